# Optimizing an MI355X kernel written in HIP

```python
import jax, jax.numpy as jnp
from jax import lax
import numpy as np

D_MODEL = 1024
BATCH = 2
SEQ = 8192
DEPTH = 1

CHUNK = 64
N_MEM = 256
EPS = 1e-6

SWA_HEADS = 16
SWA_KV_HEADS = 2
SWA_HEAD_DIM = 64
SWA_GROUP = SWA_HEADS // SWA_KV_HEADS
SWA_WINDOW = 128
SWA_WIN_CHUNKS = SWA_WINDOW // CHUNK
SWA_BLOCK = 128

GLA_HEADS = 4
GLA_KEY_DIM = D_MODEL // 2
GLA_VAL_DIM = D_MODEL
GLA_DK = GLA_KEY_DIM // GLA_HEADS
GLA_DV = GLA_VAL_DIM // GLA_HEADS
GLA_GATE_RANK = 16
GLA_GATE_NORM = 16.0

MEM_HEADS = 4
MEM_HEAD_DIM = 64
MEM_WIDTH = MEM_HEADS * MEM_HEAD_DIM

D_FF = -(-(8 * D_MODEL) // (3 * 256)) * 256

IN_SIZES = (SWA_HEADS * SWA_HEAD_DIM, SWA_KV_HEADS * SWA_HEAD_DIM, SWA_KV_HEADS * SWA_HEAD_DIM,
            GLA_KEY_DIM, GLA_KEY_DIM, GLA_VAL_DIM, GLA_VAL_DIM, GLA_GATE_RANK, 2 * D_MODEL)
IN_COLS = int(sum(IN_SIZES))
IN_OFFSETS = tuple(int(o) for o in np.cumsum(IN_SIZES)[:-1])

kernel_name = 'hybrid_swa_sinks_gla_memory_block'


def _rms(t, w):
    tf = t.astype(jnp.float32)
    y = tf * lax.rsqrt(jnp.mean(tf * tf, axis=-1, keepdims=True) + EPS)
    return y.astype(t.dtype) * w


def _swa_with_sinks(q, k, v, sinks):
    B, S = q.shape[0], q.shape[1]
    nb = S // SWA_BLOCK
    qb = q.reshape(B, nb, SWA_BLOCK, SWA_KV_HEADS, SWA_GROUP, SWA_HEAD_DIM)
    pad = ((0, 0), (SWA_BLOCK, 0), (0, 0), (0, 0))
    kp = jnp.pad(k, pad).reshape(B, nb + 1, SWA_BLOCK, SWA_KV_HEADS, SWA_HEAD_DIM)
    vp = jnp.pad(v, pad).reshape(B, nb + 1, SWA_BLOCK, SWA_KV_HEADS, SWA_HEAD_DIM)
    kb = jnp.concatenate([kp[:, :-1], kp[:, 1:]], axis=2)
    vb = jnp.concatenate([vp[:, :-1], vp[:, 1:]], axis=2)
    scale = SWA_HEAD_DIM ** -0.5
    s = jnp.einsum('bnqhgd,bnshd->bnhgqs', qb, kb).astype(jnp.float32) * scale
    n = jnp.arange(nb)[:, None, None]
    qpos = n * SWA_BLOCK + jnp.arange(SWA_BLOCK)[None, :, None]
    kpos = (n - 1) * SWA_BLOCK + jnp.arange(2 * SWA_BLOCK)[None, None, :]
    qch = qpos // CHUNK
    kch = kpos // CHUNK
    mask = (kpos >= 0) & (kch <= qch) & (kch >= qch - SWA_WIN_CHUNKS)
    s = jnp.where(mask[None, :, None, None], s, -1e30)
    sink = sinks.astype(jnp.float32).reshape(1, 1, SWA_KV_HEADS, SWA_GROUP, 1, 1)
    m = jnp.maximum(jnp.max(s, axis=-1, keepdims=True), sink)
    p = jnp.exp(s - m)
    denom = jnp.sum(p, axis=-1, keepdims=True) + jnp.exp(sink - m)
    probs = (p / denom).astype(v.dtype)
    o = jnp.einsum('bnhgqs,bnshd->bnqhgd', probs, vb)
    return o.reshape(B, S, SWA_HEADS * SWA_HEAD_DIM)


def _gla_chunk_causal(q, k, v, gk):
    B, S = q.shape[0], q.shape[1]
    nc = S // CHUNK
    f32 = jnp.float32
    r = lambda t: t.astype(f32).reshape(B, nc, CHUNK, GLA_HEADS, t.shape[-1])
    qc = r(q) * (GLA_DK ** -0.5)
    kc, vc, gc = r(k), r(v), r(gk)
    b = jnp.cumsum(gc, axis=2)
    b_end = b[:, :, -1:]
    k_dec = kc * jnp.exp(b_end - b)
    a = jnp.exp(b_end[:, :, 0])

    def step(state, xs):
        q_c, k_c, v_c, a_c = xs
        state = a_c[..., None] * state + jnp.einsum('bchk,bchv->bhkv', k_c, v_c)
        o_c = jnp.einsum('bchk,bhkv->bchv', q_c, state)
        return state, o_c

    xs = (jnp.moveaxis(qc, 1, 0), jnp.moveaxis(k_dec, 1, 0), jnp.moveaxis(vc, 1, 0), jnp.moveaxis(a, 1, 0))
    s0 = jnp.zeros((B, GLA_HEADS, GLA_DK, GLA_DV), f32)
    _, o = lax.scan(step, s0, xs)
    return jnp.moveaxis(o, 0, 1).reshape(B, S, GLA_HEADS, GLA_DV).astype(q.dtype)


def _mixer_block(h, w_in, b_gate, attn_sinks, gla_gate_w2, gla_gate_b, gla_norm_w, w_attn_o, w_gla_o, w_mix_o):
    B, S, _ = h.shape
    proj = h @ w_in
    q_a, k_a, v_a, q_g, k_g, v_g, g_g, a_lr, gates = jnp.split(proj, IN_OFFSETS, axis=-1)
    o_a = _swa_with_sinks(q_a.reshape(B, S, SWA_HEADS, SWA_HEAD_DIM),
                          k_a.reshape(B, S, SWA_KV_HEADS, SWA_HEAD_DIM),
                          v_a.reshape(B, S, SWA_KV_HEADS, SWA_HEAD_DIM), attn_sinks)
    gk = jax.nn.log_sigmoid((a_lr @ gla_gate_w2 + gla_gate_b).astype(jnp.float32)) / GLA_GATE_NORM
    o_g = _gla_chunk_causal(q_g.reshape(B, S, GLA_HEADS, GLA_DK),
                            k_g.reshape(B, S, GLA_HEADS, GLA_DK),
                            v_g.reshape(B, S, GLA_HEADS, GLA_DV),
                            gk.reshape(B, S, GLA_HEADS, GLA_DK))
    o_g = _rms(o_g, gla_norm_w) * jax.nn.silu(g_g.reshape(B, S, GLA_HEADS, GLA_DV))
    o_g = o_g.reshape(B, S, GLA_VAL_DIM)
    g_a, g_b = jnp.split(jax.nn.sigmoid(gates + b_gate), 2, axis=-1)
    merged = g_a * (o_a @ w_attn_o) + g_b * (o_g @ w_gla_o)
    return merged @ w_mix_o


def _memory_xattn(h, m, w_mem_q, w_mem_kv, w_mem_o):
    B, S, _ = h.shape
    q = (h @ w_mem_q).reshape(B, S, MEM_HEADS, MEM_HEAD_DIM)
    k, v = jnp.split(m @ w_mem_kv, 2, axis=-1)
    k = k.reshape(B, m.shape[1], MEM_HEADS, MEM_HEAD_DIM)
    v = v.reshape(B, m.shape[1], MEM_HEADS, MEM_HEAD_DIM)
    s = jnp.einsum('bshd,bmhd->bhsm', q, k).astype(jnp.float32) * (MEM_HEAD_DIM ** -0.5)
    p = jax.nn.softmax(s, axis=-1).astype(v.dtype)
    o = jnp.einsum('bhsm,bmhd->bshd', p, v).reshape(B, S, MEM_WIDTH)
    return o @ w_mem_o


def _swiglu(h, w_gate, w_up, w_down):
    return (jax.nn.silu(h @ w_gate) * (h @ w_up)) @ w_down


def setup_inputs(seed: int = 0) -> dict:
    key = jax.random.key(seed)
    ks = jax.random.split(key, 24)
    f32 = jnp.float32
    L = DEPTH

    def nrm(k, shape, fan_in):
        return jax.random.normal(k, shape, f32) * (fan_in ** -0.5)

    def gain(k, shape):
        return 1.0 + 0.02 * jax.random.normal(k, shape, f32)

    return {
        'x': jax.random.normal(ks[0], (BATCH, SEQ, D_MODEL), f32),
        'mem': jax.random.normal(ks[1], (BATCH, N_MEM, D_MODEL), f32),
        'norm_mix_w': gain(ks[2], (L, D_MODEL)),
        'w_in': nrm(ks[3], (L, D_MODEL, IN_COLS), D_MODEL),
        'b_gate': 0.02 * jax.random.normal(ks[4], (L, 2 * D_MODEL), f32),
        'attn_sinks': 0.5 * jax.random.normal(ks[5], (L, SWA_HEADS), f32),
        'gla_gate_w2': nrm(ks[6], (L, GLA_GATE_RANK, GLA_KEY_DIM), GLA_GATE_RANK),
        'gla_gate_b': 0.1 * jax.random.normal(ks[7], (L, GLA_KEY_DIM), f32),
        'gla_norm_w': gain(ks[8], (L, GLA_DV)),
        'w_attn_o': nrm(ks[9], (L, SWA_HEADS * SWA_HEAD_DIM, D_MODEL), SWA_HEADS * SWA_HEAD_DIM),
        'w_gla_o': nrm(ks[10], (L, GLA_VAL_DIM, D_MODEL), GLA_VAL_DIM),
        'w_mix_o': nrm(ks[11], (L, D_MODEL, D_MODEL), D_MODEL),
        'norm_mem_q_w': gain(ks[12], (L, D_MODEL)),
        'norm_mem_kv_w': gain(ks[13], (L, D_MODEL)),
        'w_mem_q': nrm(ks[14], (L, D_MODEL, MEM_WIDTH), D_MODEL),
        'w_mem_kv': nrm(ks[15], (L, D_MODEL, 2 * MEM_WIDTH), D_MODEL),
        'w_mem_o': nrm(ks[16], (L, MEM_WIDTH, D_MODEL), MEM_WIDTH),
        'norm_ffn_w': gain(ks[17], (L, D_MODEL)),
        'w_ffn_gate': nrm(ks[18], (L, D_MODEL, D_FF), D_MODEL),
        'w_ffn_up': nrm(ks[19], (L, D_MODEL, D_FF), D_MODEL),
        'w_ffn_down': nrm(ks[20], (L, D_FF, D_MODEL), D_FF),
        'norm_final_w': gain(ks[21], (D_MODEL,)),
    }


def reference(x, mem, norm_mix_w, w_in, b_gate, attn_sinks, gla_gate_w2, gla_gate_b, gla_norm_w,
              w_attn_o, w_gla_o, w_mix_o, norm_mem_q_w, norm_mem_kv_w, w_mem_q, w_mem_kv, w_mem_o,
              norm_ffn_w, w_ffn_gate, w_ffn_up, w_ffn_down, norm_final_w):
    for l in range(DEPTH):
        h = _rms(x, norm_mix_w[l])
        x = x + _mixer_block(h, w_in[l], b_gate[l], attn_sinks[l], gla_gate_w2[l], gla_gate_b[l],
                             gla_norm_w[l], w_attn_o[l], w_gla_o[l], w_mix_o[l])
        x = x + _memory_xattn(_rms(x, norm_mem_q_w[l]), _rms(mem, norm_mem_kv_w[l]),
                              w_mem_q[l], w_mem_kv[l], w_mem_o[l])
        x = x + _swiglu(_rms(x, norm_ffn_w[l]), w_ffn_gate[l], w_ffn_up[l], w_ffn_down[l])
    return _rms(x, norm_final_w)
```

```cpp
#define MK_N_LAUNCHES 1
#include <hip/hip_runtime.h>
#include <hip/hip_cooperative_groups.h>
#include <cstdio>
#include <cstdint>
#include <cstddef>
namespace cg = cooperative_groups;
namespace pg8 {
#define PG8_LAS __attribute__((address_space(3)))
typedef unsigned short bf16_t;
typedef short bf16x8 __attribute__((ext_vector_type(8)));
typedef float f32x4 __attribute__((ext_vector_type(4)));
typedef unsigned u32x4 __attribute__((ext_vector_type(4)));
constexpr int BM = 256, BK = 64, HALF = 128, HTB = HALF * BK * 2  , STAGE_BYTES = 8 * HTB, NXCD = 8, WGM = 8;

__host__ __device__ __forceinline__ int lds_byte(int r, int c) { const int st = (r >> 4) * 2 + (c >> 5), rr = r & 15, cc = c & 31, ob = rr * 64 + cc * 2; return st * 1024 + (ob ^ (((ob >> 9) & 1) << 5)); }
__host__ __device__ __forceinline__ void stage_rc(int b, int& R, int& C) { const int st = b / 1024, sb = b % 1024, swz = sb ^ (((sb >> 9) & 1) << 5); R = (st >> 1) * 16 + swz / 64; C = (st & 1) * 32 + (swz % 64) / 2; }
__host__ __device__ __forceinline__ int perm32(int rho) { const int n = rho >> 4, i = rho & 15; return 8 * (i >> 2) + 4 * n + (i & 3); }

struct Unit { int pm, pn; };
struct Gemm { const bf16_t* A; const bf16_t* Bt; int M, N, K; };

struct StaticOrder {
    int nM, nN, nwg, G, c;
    __host__ __device__ void init(int M, int N, int G_, int c_) { nM = M / BM; nN = N / BM; nwg = nM * nN; G = G_; c = c_; }
    __host__ __device__ bool next(int i, Unit& u) const {
        const long L = (long)i * G + c; if (L >= nwg) return false;
        int wgid = (int)L; { const int q = nwg / NXCD, r = nwg % NXCD, xcd = wgid % NXCD, off = wgid / NXCD; wgid = (xcd < r ? xcd * (q + 1) : r * (q + 1) + (xcd - r) * q) + off; }
        const int nig = WGM * nN, gid = wgid / nig, fm = gid * WGM, gsz = (nM - fm) < WGM ? (nM - fm) : WGM;
        u.pm = fm + ((wgid % nig) % gsz); u.pn = (wgid % nig) / gsz; return true;
    }
    __device__ __forceinline__ void a_ready(const Unit&) const {}
    __device__ __forceinline__ void done(const Unit&) const {}
};

__device__ __forceinline__ unsigned cvt_pk_bf16(float lo, float hi) { unsigned r; asm volatile("v_cvt_pk_bf16_f32 %0, %1, %2" : "=v"(r) : "v"(lo), "v"(hi)); return r; }
typedef float f32x2 __attribute__((ext_vector_type(2)));
struct OneUnit {
    int pm, pn;
    __host__ __device__ bool next(int i, Unit& u) const { if (i != 0) return false; u.pm = pm; u.pn = pn; return true; }
    __device__ __forceinline__ void a_ready(const Unit&) const {}
    __device__ __forceinline__ void done(const Unit&) const {}
};
struct StrideOrder {
    int first, stride, n;
    __host__ __device__ bool next(int i, Unit& u) const { const int L = first + i * stride; if (L >= n) return false; u.pm = L >> 2; u.pn = L & 3; return true; }
    __device__ __forceinline__ void a_ready(const Unit&) const {}
    __device__ __forceinline__ void done(const Unit&) const {}
};
typedef float f32x2_t __attribute__((ext_vector_type(2))); typedef __bf16 bf16x2_t __attribute__((ext_vector_type(2)));
__device__ __forceinline__ unsigned cvtpk(float lo, float hi) { f32x2_t v = {lo, hi}; bf16x2_t b = __builtin_convertvector(v, bf16x2_t); return __builtin_bit_cast(unsigned, b); }
__device__ __forceinline__ void st8(bf16_t* p, f32x4 v0, f32x4 v1) { u32x4 w; w.x = cvtpk(v0[0], v0[1]); w.y = cvtpk(v0[2], v0[3]); w.z = cvtpk(v1[0], v1[1]); w.w = cvtpk(v1[2], v1[3]); __builtin_nontemporal_store(w, (u32x4*)p); }
__device__ __forceinline__ void ld8(const bf16_t* p, f32x4& v0, f32x4& v1) { const u32x4 w = *(const u32x4*)p;
    v0[0] = __uint_as_float(w.x << 16); v0[1] = __uint_as_float(w.x & 0xffff0000u); v0[2] = __uint_as_float(w.y << 16); v0[3] = __uint_as_float(w.y & 0xffff0000u);
    v1[0] = __uint_as_float(w.z << 16); v1[1] = __uint_as_float(w.z & 0xffff0000u); v1[2] = __uint_as_float(w.w << 16); v1[3] = __uint_as_float(w.w & 0xffff0000u); }
__device__ __forceinline__ float sigm(float v) { return __builtin_amdgcn_rcpf(1.f + __expf(-v)); }
__device__ __forceinline__ f32x4 sigm4(f32x4 v) { return (f32x4){sigm(v[0]), sigm(v[1]), sigm(v[2]), sigm(v[3])}; }
__device__ __forceinline__ float dot4(f32x4 a) { return (a[0] * a[0] + a[1] * a[1]) + (a[2] * a[2] + a[3] * a[3]); }

struct EpiProj {
    static constexpr bool PERM = true, AFTER_DRAIN = false;
    bf16_t *QA, *KA, *VTa, *QG, *KG, *VTg, *GG, *GT; const float* bgate;
    __device__ __forceinline__ void operator()(const f32x4 (&acc)[2][2][4][2], const Unit& u, int wr, int wc, int fr, int fq) const {
        const int row0 = u.pm * BM + wr * 64 + fr;
#pragma unroll
        for (int bj = 0; bj < 2; ++bj) {
            const int hb = 2 * u.pn + bj;
            int mode = 0, ld, c0; bf16_t* dst;
            if (hb < 8) { dst = QA; ld = 1024; c0 = 128 * hb; }
            else if (hb == 8) { dst = KA; ld = 128; c0 = 0; }
            else if (hb == 9) { mode = 1; dst = VTa; ld = 128; c0 = 0; }
            else if (hb < 14) { dst = QG; ld = 512; c0 = 128 * (hb - 10); }
            else if (hb < 18) { dst = KG; ld = 512; c0 = 128 * (hb - 14); }
            else if (hb < 26) { mode = 1; dst = VTg; ld = 1024; c0 = 128 * (hb - 18); }
            else if (hb < 34) { mode = 2; dst = GG; ld = 1024; c0 = 128 * (hb - 26); }
            else { mode = 3; dst = GT; ld = 2048; c0 = 128 * (hb - 34); }
            const int cl = c0 + wc * 32 + 8 * fq;
            if (mode == 1) {
                const int b = (u.pm * BM) >> 13, t0 = (row0 & 8191);
                unsigned short* pb = (unsigned short*)dst + ((size_t)(b * ld + cl)) * 8192 + t0;
#pragma unroll
                for (int ai = 0; ai < 2; ++ai)
#pragma unroll
                    for (int m = 0; m < 4; ++m) {
                        unsigned short* p = pb + ai * HALF + m * 16;
#pragma unroll
                        for (int n = 0; n < 2; ++n) { const f32x4 v = acc[ai][bj][m][n]; const unsigned w0 = cvtpk(v[0], v[1]), w1 = cvtpk(v[2], v[3]);
                            p[(size_t)(4 * n + 0) * 8192] = (unsigned short)(w0 & 0xffffu); p[(size_t)(4 * n + 1) * 8192] = (unsigned short)(w0 >> 16);
                            p[(size_t)(4 * n + 2) * 8192] = (unsigned short)(w1 & 0xffffu); p[(size_t)(4 * n + 3) * 8192] = (unsigned short)(w1 >> 16); }
                    }
            } else {
                f32x4 b0 = {0.f, 0.f, 0.f, 0.f}, b1 = {0.f, 0.f, 0.f, 0.f};
                if (mode == 3) { b0 = *(const f32x4*)(bgate + cl); b1 = *(const f32x4*)(bgate + cl + 4); }
#pragma unroll
                for (int ai = 0; ai < 2; ++ai)
#pragma unroll
                    for (int m = 0; m < 4; ++m) {
                        f32x4 v0 = acc[ai][bj][m][0], v1 = acc[ai][bj][m][1];
                        if (mode == 3) { v0 = v0 + b0; v1 = v1 + b1; }
                        st8(dst + (size_t)(row0 + ai * HALF + m * 16) * ld + cl, v0, v1);
                    }
            }
        }
    }
};
struct EpiMemKV {
    static constexpr bool PERM = true, AFTER_DRAIN = false;
    bf16_t *KM, *VmT;
    __device__ __forceinline__ void operator()(const f32x4 (&acc)[2][2][4][2], const Unit& u, int wr, int wc, int fr, int fq) const {
        const int rl = wr * 64 + fr;
#pragma unroll
        for (int bj = 0; bj < 2; ++bj) {
            const int cl = bj * HALF + wc * 32 + 8 * fq;
#pragma unroll
            for (int ai = 0; ai < 2; ++ai)
#pragma unroll
                for (int m = 0; m < 4; ++m) {
                    const int r = rl + ai * HALF + m * 16;
                    if (u.pn == 0) st8(KM + (size_t)(u.pm * BM + r) * 256 + cl, acc[ai][bj][m][0], acc[ai][bj][m][1]);
                    else { unsigned short* p = (unsigned short*)VmT + ((size_t)(u.pm * 256 + cl)) * 256 + r;
#pragma unroll
                        for (int n = 0; n < 2; ++n) { const f32x4 v = acc[ai][bj][m][n]; const unsigned w0 = cvtpk(v[0], v[1]), w1 = cvtpk(v[2], v[3]);
                            p[(4 * n + 0) * 256] = (unsigned short)(w0 & 0xffffu); p[(4 * n + 1) * 256] = (unsigned short)(w0 >> 16);
                            p[(4 * n + 2) * 256] = (unsigned short)(w1 & 0xffffu); p[(4 * n + 3) * 256] = (unsigned short)(w1 >> 16); } }
                }
        }
    }
};
struct EpiGate {
    static constexpr bool PERM = true, AFTER_DRAIN = false;
    const bf16_t* GT; bf16_t* TMP; bf16_t* OUT; int second;
    __device__ __forceinline__ void operator()(const f32x4 (&acc)[2][2][4][2], const Unit& u, int wr, int wc, int fr, int fq) const {
        const int row0 = u.pm * BM + wr * 64 + fr, c0 = u.pn * BM + wc * 32 + 8 * fq;
#pragma unroll
        for (int ai = 0; ai < 2; ++ai) {
            u32x4 gv[4][2], tv[4][2];
#pragma unroll
            for (int m = 0; m < 4; ++m)
#pragma unroll
                for (int bj = 0; bj < 2; ++bj) { const size_t row = (size_t)(row0 + ai * HALF + m * 16); const int c = c0 + bj * HALF;
                    gv[m][bj] = *(const u32x4*)(GT + row * 2048 + (second ? 1024 : 0) + c);
                    if (second) tv[m][bj] = *(const u32x4*)(TMP + row * 1024 + c); }
#pragma unroll
            for (int m = 0; m < 4; ++m)
#pragma unroll
                for (int bj = 0; bj < 2; ++bj) { const size_t row = (size_t)(row0 + ai * HALF + m * 16); const int c = c0 + bj * HALF;
                    const u32x4 w = gv[m][bj];
                    const f32x4 g0 = {__uint_as_float(w.x << 16), __uint_as_float(w.x & 0xffff0000u), __uint_as_float(w.y << 16), __uint_as_float(w.y & 0xffff0000u)};
                    const f32x4 g1 = {__uint_as_float(w.z << 16), __uint_as_float(w.z & 0xffff0000u), __uint_as_float(w.w << 16), __uint_as_float(w.w & 0xffff0000u)};
                    f32x4 v0 = acc[ai][bj][m][0] * sigm4(g0), v1 = acc[ai][bj][m][1] * sigm4(g1);
                    if (second) { const u32x4 t = tv[m][bj];
                        v0 += (f32x4){__uint_as_float(t.x << 16), __uint_as_float(t.x & 0xffff0000u), __uint_as_float(t.y << 16), __uint_as_float(t.y & 0xffff0000u)};
                        v1 += (f32x4){__uint_as_float(t.z << 16), __uint_as_float(t.z & 0xffff0000u), __uint_as_float(t.w << 16), __uint_as_float(t.w & 0xffff0000u)};
                        st8(OUT + row * 1024 + c, v0, v1); }
                    else st8(TMP + row * 1024 + c, v0, v1); }
        }
    }
};
struct EpiResid {
    static constexpr bool PERM = true, AFTER_DRAIN = false;
    const float* basef; const bf16_t* baseb; float* out; bf16_t* xb; float* ssq;
    __device__ __forceinline__ void operator()(const f32x4 (&acc)[2][2][4][2], const Unit& u, int wr, int wc, int fr, int fq) const {
        const int row0 = u.pm * BM + wr * 64 + fr, c0 = u.pn * BM + wc * 32 + 8 * fq;
#pragma unroll
        for (int ai = 0; ai < 2; ++ai) {
            f32x4 bs[4][2][2];
#pragma unroll
            for (int m = 0; m < 4; ++m)
#pragma unroll
                for (int bj = 0; bj < 2; ++bj) { const size_t off = (size_t)(row0 + ai * HALF + m * 16) * 1024 + c0 + bj * HALF;
                    if (basef) { bs[m][bj][0] = *(const f32x4*)(basef + off); bs[m][bj][1] = *(const f32x4*)(basef + off + 4); } else ld8(baseb + off, bs[m][bj][0], bs[m][bj][1]); }
#pragma unroll
            for (int m = 0; m < 4; ++m) {
                const size_t row = (size_t)(row0 + ai * HALF + m * 16); float s = 0.f;
#pragma unroll
                for (int bj = 0; bj < 2; ++bj) {
                    const int c = c0 + bj * HALF;
                    const f32x4 x0 = bs[m][bj][0] + acc[ai][bj][m][0], x1 = bs[m][bj][1] + acc[ai][bj][m][1];
                    if (out) { *(f32x4*)(out + row * 1024 + c) = x0; *(f32x4*)(out + row * 1024 + c + 4) = x1; }
                    if (xb) st8(xb + row * 1024 + c, x0, x1);
                    s += dot4(x0) + dot4(x1);
                }
                if (ssq) { s += __shfl_xor(s, 16); s += __shfl_xor(s, 32); if (fq == 0) atomicAdd(ssq + row, s); }
            }
        }
    }
};
struct EpiFinal {
    static constexpr bool PERM = true, AFTER_DRAIN = true;
    const bf16_t* base; float* out; const float* wf; float* xslots; unsigned* cnt;
    __device__ __forceinline__ void fused(f32x4 (&acc)[2][2][4][2], const Unit& u, int wr, int wc, int fr, int fq, PG8_LAS unsigned char* lds, int wid, int lane) const {
        PG8_LAS float* P = (PG8_LAS float*)lds;
        PG8_LAS float* R = (PG8_LAS float*)(lds + 4096);
        const int row0 = u.pm * BM + wr * 64 + fr, c0 = u.pn * BM + wc * 32 + 8 * fq;
#pragma unroll
        for (int ai = 0; ai < 2; ++ai) {
            f32x4 bs[4][2][2];
#pragma unroll
            for (int m = 0; m < 4; ++m)
#pragma unroll
                for (int bj = 0; bj < 2; ++bj) ld8(base + (size_t)(row0 + ai * HALF + m * 16) * 1024 + c0 + bj * HALF, bs[m][bj][0], bs[m][bj][1]);
#pragma unroll
            for (int m = 0; m < 4; ++m) {
                float s = 0.f;
#pragma unroll
                for (int bj = 0; bj < 2; ++bj) { acc[ai][bj][m][0] += bs[m][bj][0]; acc[ai][bj][m][1] += bs[m][bj][1]; s += dot4(acc[ai][bj][m][0]) + dot4(acc[ai][bj][m][1]); }
                s += __shfl_xor(s, 16); s += __shfl_xor(s, 32);
                if (fq == 0) P[(ai * HALF + wr * 64 + m * 16 + fr) * 4 + wc] = s;
            }
        }
        asm volatile("s_waitcnt lgkmcnt(0)" ::: "memory"); __builtin_amdgcn_s_barrier(); asm volatile("" ::: "memory");
        const int tid = wid * 64 + lane;
        if (tid < 256) {
            const float s = (P[tid * 4] + P[tid * 4 + 1]) + (P[tid * 4 + 2] + P[tid * 4 + 3]);
            __hip_atomic_store(xslots + (size_t)(u.pm * BM + tid) * 4 + u.pn, s, __ATOMIC_RELAXED, __HIP_MEMORY_SCOPE_AGENT);
            asm volatile("s_waitcnt vmcnt(0)" ::: "memory");
            if (lane == 0) __hip_atomic_fetch_add(cnt + 64 * u.pm, 1u, __ATOMIC_RELAXED, __HIP_MEMORY_SCOPE_AGENT);
        }
        if (wid == 0) {
            unsigned sp = 0;
            while ((unsigned)__builtin_amdgcn_readfirstlane(__hip_atomic_load(cnt + 64 * u.pm, __ATOMIC_RELAXED, __HIP_MEMORY_SCOPE_AGENT)) < 16u) { __builtin_amdgcn_s_sleep(2); if (++sp > (1u << 24)) break; }
            __builtin_amdgcn_fence(__ATOMIC_ACQUIRE, "agent");
        }
        asm volatile("s_waitcnt vmcnt(0) lgkmcnt(0)" ::: "memory"); __builtin_amdgcn_s_barrier(); asm volatile("" ::: "memory");
        if (tid < 256) {
            const float* sl = xslots + (size_t)(u.pm * BM + tid) * 4;
            const float s = (__hip_atomic_load(sl, __ATOMIC_RELAXED, __HIP_MEMORY_SCOPE_AGENT) + __hip_atomic_load(sl + 1, __ATOMIC_RELAXED, __HIP_MEMORY_SCOPE_AGENT))
                          + (__hip_atomic_load(sl + 2, __ATOMIC_RELAXED, __HIP_MEMORY_SCOPE_AGENT) + __hip_atomic_load(sl + 3, __ATOMIC_RELAXED, __HIP_MEMORY_SCOPE_AGENT));
            R[tid] = 1.0f / sqrtf(s * (1.f / 1024.f) + 1e-6f);
        }
        asm volatile("s_waitcnt vmcnt(0) lgkmcnt(0)" ::: "memory"); __builtin_amdgcn_s_barrier(); asm volatile("" ::: "memory");
        f32x4 w4[2][2];
#pragma unroll
        for (int bj = 0; bj < 2; ++bj) { w4[bj][0] = *(const f32x4*)(wf + c0 + bj * HALF); w4[bj][1] = *(const f32x4*)(wf + c0 + bj * HALF + 4); }
#pragma unroll
        for (int ai = 0; ai < 2; ++ai)
#pragma unroll
            for (int m = 0; m < 4; ++m) {
                const int rl = ai * HALF + wr * 64 + m * 16 + fr; const float r = R[rl]; float* op = out + (size_t)(u.pm * BM + rl) * 1024 + c0;
#pragma unroll
                for (int bj = 0; bj < 2; ++bj) { *(f32x4*)(op + bj * HALF) = acc[ai][bj][m][0] * r * w4[bj][0]; *(f32x4*)(op + bj * HALF + 4) = acc[ai][bj][m][1] * r * w4[bj][1]; }
            }
    }
};
struct EpiScaleQ {
    static constexpr bool PERM = true, AFTER_DRAIN = false;
    bf16_t* QM; const float* ssq;
    __device__ __forceinline__ void operator()(const f32x4 (&acc)[2][2][4][2], const Unit& u, int wr, int wc, int fr, int fq) const {
        const int row0 = u.pm * BM + wr * 64 + fr;
        float sq[2][4];
#pragma unroll
        for (int ai = 0; ai < 2; ++ai)
#pragma unroll
            for (int m = 0; m < 4; ++m) sq[ai][m] = ssq[row0 + ai * HALF + m * 16];
#pragma unroll
        for (int ai = 0; ai < 2; ++ai)
#pragma unroll
            for (int m = 0; m < 4; ++m) {
                const size_t row = (size_t)(row0 + ai * HALF + m * 16);
                const float r = 0.125f * __builtin_amdgcn_rsqf(sq[ai][m] * (1.f / 1024.f) + 1e-6f);
#pragma unroll
                for (int bj = 0; bj < 2; ++bj) st8(QM + row * 256 + bj * HALF + wc * 32 + 8 * fq, acc[ai][bj][m][0] * r, acc[ai][bj][m][1] * r);
            }
    }
};
struct EpiSwiglu {
    static constexpr bool PERM = true, AFTER_DRAIN = false;
    bf16_t* ACT; const float* ssq;
    __device__ __forceinline__ void operator()(const f32x4 (&acc)[2][2][4][2], const Unit& u, int wr, int wc, int fr, int fq) const {
        const int row0 = u.pm * BM + wr * 64 + fr;
        float sq[2][4];
#pragma unroll
        for (int ai = 0; ai < 2; ++ai)
#pragma unroll
            for (int m = 0; m < 4; ++m) sq[ai][m] = ssq[row0 + ai * HALF + m * 16];
#pragma unroll
        for (int ai = 0; ai < 2; ++ai)
#pragma unroll
            for (int m = 0; m < 4; ++m) {
                const size_t row = (size_t)(row0 + ai * HALF + m * 16);
                const float r = __builtin_amdgcn_rsqf(sq[ai][m] * (1.f / 1024.f) + 1e-6f);
                const f32x4 g0 = acc[ai][0][m][0] * r, g1 = acc[ai][0][m][1] * r, u0 = acc[ai][1][m][0] * r, u1 = acc[ai][1][m][1] * r;
                st8(ACT + row * 2816 + u.pn * HALF + wc * 32 + 8 * fq, g0 * sigm4(g0) * u0, g1 * sigm4(g1) * u1);
            }
    }
};
template <class Epi, class Sched, bool ALIGN_EPI = false, bool SP2 = false>
__device__ __forceinline__ void gemm_phase(PG8_LAS unsigned char* lds, const Gemm g, const Sched& S, const Epi& E) {
    const int tid = threadIdx.x, wid = __builtin_amdgcn_readfirstlane(tid >> 6), lane = tid & 63, wr = wid >> 2, wc = wid & 3, fr = lane & 15, fq = lane >> 4;
    const int K = g.K, nt = K / BK;
    unsigned voffA[2], voffB[2];
#pragma unroll
    for (int i = 0; i < 2; ++i) { int R, C; stage_rc(tid * 16 + i * 8192, R, C); const int Rb = Epi::PERM ? ((R & ~31) + perm32(R & 31)) : R;
        voffA[i] = (unsigned)(R * K + C) * 2u; voffB[i] = (unsigned)(Rb * K + C) * 2u; }
    const size_t kstep = (size_t)(BK * 2);
    const size_t hstep = (size_t)HALF * K * 2;
    const size_t tstep = 2 * hstep;
    const unsigned ldsw = (unsigned)wid * 1024u;
    const int aoff = lds_byte(wr * 64 + fr, fq * 8), boff = lds_byte(wc * 32 + fr, fq * 8);
#define PG8_SA(b, h) (((b) * 2 + (h)) * HTB)
#define PG8_SB(b, h) ((4 + (b) * 2 + (h)) * HTB)
#define PG8_STAGE(bufoff, gbase, voff) do { _Pragma("unroll") for (int _i = 0; _i < 2; ++_i) \
        __builtin_amdgcn_global_load_lds((const unsigned*)((const char*)(gbase) + (voff)[_i]), (PG8_LAS unsigned*)(lds + (bufoff) + ldsw + _i * 8192), 16, 0, 0); } while (0)
#define PG8_LDA(dst, b, h) do { _Pragma("unroll") for (int m = 0; m < 4; ++m) _Pragma("unroll") for (int k = 0; k < 2; ++k) dst[m][k] = *(const PG8_LAS bf16x8*)(lds + PG8_SA(b, h) + aoff + m * 2048 + k * 1024); } while (0)
#define PG8_LDB(dst, b, h) do { _Pragma("unroll") for (int n = 0; n < 2; ++n) _Pragma("unroll") for (int k = 0; k < 2; ++k) dst[n][k] = *(const PG8_LAS bf16x8*)(lds + PG8_SB(b, h) + boff + n * 2048 + k * 1024); } while (0)
#define PG8_MMA(ai, bj, At, Bt) do { __builtin_amdgcn_s_setprio(1); _Pragma("unroll") for (int m = 0; m < 4; ++m) _Pragma("unroll") for (int n = 0; n < 2; ++n) _Pragma("unroll") for (int k = 0; k < 2; ++k) \
        acc[ai][bj][m][n] = __builtin_amdgcn_mfma_f32_16x16x32_bf16(Bt[n][k], At[m][k], acc[ai][bj][m][n], 0, 0, 0); __builtin_amdgcn_s_setprio(0); } while (0)
#define PG8_WAIT_V(n) asm volatile("s_waitcnt vmcnt(" #n ")" ::: "memory")
#define PG8_WAIT_L(n) asm volatile("s_waitcnt lgkmcnt(" #n ")" ::: "memory")
#define PG8_BAR __builtin_amdgcn_s_barrier()
#define PG8_SCHED __builtin_amdgcn_sched_barrier(0)
    Unit cur, nxt; int ui = 0;
    if (!S.next(0, cur)) return;
    f32x4 acc[2][2][4][2];
#pragma unroll
    for (int a = 0; a < 2; ++a)
#pragma unroll
        for (int b = 0; b < 2; ++b)
#pragma unroll
            for (int m = 0; m < 4; ++m)
#pragma unroll
                for (int n = 0; n < 2; ++n) acc[a][b][m][n] = (f32x4){0.f, 0.f, 0.f, 0.f};
    bf16x8 At[4][2], B0[2][2], B1[2][2];
    const char* cA = (const char*)g.A + (size_t)cur.pm * tstep; const char* cB = (const char*)g.Bt + (size_t)cur.pn * tstep;
    S.a_ready(cur);
    if constexpr (SP2) {
        PG8_STAGE(PG8_SB(0, 0), cB, voffB); PG8_STAGE(PG8_SB(0, 1), cB + hstep, voffB); PG8_STAGE(PG8_SA(0, 0), cA, voffA); PG8_STAGE(PG8_SA(0, 1), cA + hstep, voffA);
        if (wr == 1) PG8_BAR;
        PG8_WAIT_V(2); PG8_BAR;
        PG8_STAGE(PG8_SB(1, 0), cB + kstep, voffB); PG8_STAGE(PG8_SA(1, 0), cA + kstep, voffA); PG8_STAGE(PG8_SB(1, 1), cB + hstep + kstep, voffB);
        PG8_WAIT_V(6); PG8_BAR;
    } else {
        PG8_STAGE(PG8_SB(0, 0), cB, voffB); PG8_STAGE(PG8_SA(0, 0), cA, voffA); PG8_STAGE(PG8_SB(0, 1), cB + hstep, voffB); PG8_STAGE(PG8_SA(0, 1), cA + hstep, voffA);
        if (wr == 1) PG8_BAR;
        PG8_WAIT_V(4); PG8_BAR;
        PG8_STAGE(PG8_SB(1, 0), cB + kstep, voffB); PG8_STAGE(PG8_SA(1, 0), cA + kstep, voffA); PG8_STAGE(PG8_SB(1, 1), cB + hstep + kstep, voffB);
        PG8_WAIT_V(6); PG8_BAR;
    }
    for (;;) {
        const bool has_next = S.next(ui + 1, nxt);
        const char* nA = has_next ? (const char*)g.A + (size_t)nxt.pm * tstep : cA; const char* nB = has_next ? (const char*)g.Bt + (size_t)nxt.pn * tstep : cB;
        for (int t = 0; t < nt; t += 2) {
            const bool last = (t == nt - 2);
            const char* a1 = cA + (size_t)(t + 1) * kstep;
            const char* a2 = last ? nA : cA + (size_t)(t + 2) * kstep; const char* b2 = last ? nB : cB + (size_t)(t + 2) * kstep;
            const char* a3 = a2 + kstep; const char* b3 = b2 + kstep;
            if (last && has_next) S.a_ready(nxt);
            if constexpr (SP2) {
            PG8_LDB(B0, 0, 0); PG8_LDB(B1, 0, 1); PG8_SCHED; PG8_LDA(At, 0, 0); PG8_STAGE(PG8_SA(1, 1), a1 + hstep, voffA);
            PG8_WAIT_V(8); PG8_WAIT_L(0); PG8_BAR; PG8_MMA(0, 0, At, B0); PG8_MMA(0, 1, At, B1); PG8_BAR; PG8_SCHED;
            PG8_LDA(At, 0, 1); PG8_STAGE(PG8_SB(0, 0), b2, voffB); PG8_STAGE(PG8_SB(0, 1), b2 + hstep, voffB); PG8_STAGE(PG8_SA(0, 0), a2, voffA);
            PG8_WAIT_V(8); PG8_WAIT_L(0); PG8_BAR; PG8_MMA(1, 0, At, B0); PG8_MMA(1, 1, At, B1); PG8_BAR; PG8_SCHED;
            PG8_LDB(B0, 1, 0); PG8_LDB(B1, 1, 1); PG8_SCHED; PG8_LDA(At, 1, 0); PG8_STAGE(PG8_SA(0, 1), a2 + hstep, voffA);
            PG8_WAIT_V(8); PG8_WAIT_L(0); PG8_BAR; PG8_MMA(0, 0, At, B0); PG8_MMA(0, 1, At, B1); PG8_BAR; PG8_SCHED;
            PG8_LDA(At, 1, 1); PG8_STAGE(PG8_SB(1, 0), b3, voffB); PG8_STAGE(PG8_SB(1, 1), b3 + hstep, voffB); PG8_STAGE(PG8_SA(1, 0), a3, voffA);
            PG8_WAIT_V(8); PG8_WAIT_L(0); PG8_BAR; PG8_MMA(1, 0, At, B0); PG8_MMA(1, 1, At, B1); PG8_BAR; PG8_SCHED;
            } else {
            PG8_LDB(B0, 0, 0); PG8_SCHED; PG8_LDA(At, 0, 0); PG8_STAGE(PG8_SA(1, 1), a1 + hstep, voffA);
            PG8_WAIT_L(8); PG8_BAR; PG8_WAIT_L(0); PG8_MMA(0, 0, At, B0); PG8_BAR; PG8_SCHED;
            PG8_LDB(B1, 0, 1); PG8_STAGE(PG8_SB(0, 0), b2, voffB);
            PG8_BAR; PG8_WAIT_L(0); PG8_MMA(0, 1, At, B1); PG8_BAR;
            PG8_LDA(At, 0, 1); PG8_STAGE(PG8_SA(0, 0), a2, voffA);
            PG8_BAR; PG8_WAIT_L(0); PG8_MMA(1, 0, At, B0); PG8_BAR; PG8_SCHED;
            PG8_STAGE(PG8_SB(0, 1), b2 + hstep, voffB);
            PG8_WAIT_V(6); PG8_BAR; PG8_MMA(1, 1, At, B1); PG8_BAR;
            PG8_LDB(B0, 1, 0); PG8_SCHED; PG8_LDA(At, 1, 0); PG8_STAGE(PG8_SA(0, 1), a2 + hstep, voffA);
            PG8_WAIT_L(8); PG8_BAR; PG8_WAIT_L(0); PG8_MMA(0, 0, At, B0); PG8_BAR; PG8_SCHED;
            PG8_LDB(B1, 1, 1); PG8_STAGE(PG8_SB(1, 0), b3, voffB);
            PG8_BAR; PG8_WAIT_L(0); PG8_MMA(0, 1, At, B1); PG8_BAR;
            PG8_LDA(At, 1, 1); PG8_STAGE(PG8_SA(1, 0), a3, voffA);
            PG8_BAR; PG8_WAIT_L(0); PG8_MMA(1, 0, At, B0); PG8_BAR; PG8_SCHED;
            PG8_STAGE(PG8_SB(1, 1), b3 + hstep, voffB);
            PG8_WAIT_V(6); PG8_BAR; PG8_MMA(1, 1, At, B1); PG8_BAR;
            }
        }
        if constexpr (ALIGN_EPI) { if (wr == 0) PG8_BAR; }
        if constexpr (!Epi::AFTER_DRAIN) { E(acc, cur, wr, wc, fr, fq); S.done(cur); }
        if (!has_next) break;
#pragma unroll
        for (int a = 0; a < 2; ++a)
#pragma unroll
            for (int b = 0; b < 2; ++b)
#pragma unroll
                for (int m = 0; m < 4; ++m)
#pragma unroll
                    for (int n = 0; n < 2; ++n) acc[a][b][m][n] = (f32x4){0.f, 0.f, 0.f, 0.f};
        cur = nxt; cA = nA; cB = nB; ++ui;
        if constexpr (ALIGN_EPI) { if (wr == 1) PG8_BAR; }
    }
    PG8_WAIT_V(0);
    if constexpr (!ALIGN_EPI) { if (wr == 0) PG8_BAR; }
    PG8_BAR;
    if constexpr (Epi::AFTER_DRAIN) { E.fused(acc, cur, wr, wc, fr, fq, lds, wid, lane); S.done(cur); }
#undef PG8_SA
#undef PG8_SB
#undef PG8_STAGE
#undef PG8_LDA
#undef PG8_LDB
#undef PG8_MMA
#undef PG8_WAIT_V
#undef PG8_WAIT_L
#undef PG8_BAR
#undef PG8_SCHED
}
}
#define GAS __attribute__((address_space(1)))
#define LAS __attribute__((address_space(3)))
typedef unsigned short bf16;
typedef unsigned v4u __attribute__((ext_vector_type(4)));
typedef unsigned v2u __attribute__((ext_vector_type(2)));
typedef float f32x4 __attribute__((ext_vector_type(4)));
typedef float f32x16 __attribute__((ext_vector_type(16)));
typedef short bf16x8 __attribute__((ext_vector_type(8)));
typedef short s16x4 __attribute__((ext_vector_type(4)));
using pg8::cvtpk;
#define MFMA16(a, b, c) __builtin_amdgcn_mfma_f32_16x16x32_bf16((a), (b), (c), 0, 0, 0)
#define MFMA32(a, b, c) __builtin_amdgcn_mfma_f32_32x32x16_bf16((a), (b), (c), 0, 0, 0)
#define LDS_WAIT() asm volatile("s_waitcnt lgkmcnt(0)" ::: "memory")

#define XB_TMO      128
#define XB_XCNT(j)  (256  + 64 * (j))
#define XB_XSUB(j)  (1280 + 64 * (j))
#define XB_XGEN(j)  (2304 + 64 * (j))
#define XB_TOP      3328
#define XB_TOPGEN   3392
#define XCD_BAR_WORDS 3456
#define XB_SPIN_CAP (1u << 18)

__device__ __forceinline__ unsigned xb_ld(unsigned* p)              { return __hip_atomic_load(p, __ATOMIC_RELAXED, __HIP_MEMORY_SCOPE_AGENT); }
__device__ __forceinline__ unsigned xb_add(unsigned* p, unsigned v) { return __hip_atomic_fetch_add(p, v, __ATOMIC_RELAXED, __HIP_MEMORY_SCOPE_AGENT); }
__device__ __forceinline__ unsigned xb_xcc_id() { return (unsigned)__builtin_amdgcn_s_getreg((3 << 11) | 20) & 0xFu; }
#define XB_SPIN(cond, bar) do { unsigned _sp = 0; while (cond) { __builtin_amdgcn_s_sleep(1); \
    if ((++_sp & 255u) == 0u) { if (xb_ld(&(bar)[XB_TMO])) break; if (_sp > XB_SPIN_CAP) { atomicAdd(&(bar)[XB_TMO], 1u); break; } } } } while (0)

struct XcdBarrier {
    unsigned* bar; unsigned x;
    volatile LAS unsigned* st;
};

__device__ __forceinline__ XcdBarrier xcd_barrier_post(unsigned* bar, volatile LAS unsigned* st) {
    XcdBarrier b; b.bar = bar; b.x = xb_xcc_id(); b.st = st;
    if (threadIdx.x == 0) (void)xb_add(&bar[XB_XCNT(b.x)], 1u);
    return b;
}
__device__ __forceinline__ void xcd_barrier_complete(unsigned* bar, unsigned x, unsigned& nloc, unsigned& nx) {
    const unsigned G = gridDim.x * gridDim.y * gridDim.z;
    unsigned sum, cnt, mine, sp = 0u;
    for (;;) {
        sum = 0u; cnt = 0u; mine = 0u;
#pragma unroll
        for (unsigned j = 0; j < 16; ++j) { const unsigned c = xb_ld(&bar[XB_XCNT(j)]); sum += c; cnt += (c > 0u) ? 1u : 0u; mine = (j == x) ? c : mine; }
        if (sum == G) break;
        __builtin_amdgcn_s_sleep(1);
        if ((++sp & 255u) == 0u) { if (xb_ld(&bar[XB_TMO])) break; if (sp > XB_SPIN_CAP) { atomicAdd(&bar[XB_TMO], 1u); break; } }
    }
    nloc = mine > 0u ? mine : 1u; nx = cnt > 0u ? cnt : 1u;
}

__device__ __forceinline__ void xcd_barrier(const XcdBarrier& b) {
    asm volatile("s_waitcnt vmcnt(0)" ::: "memory");
    __syncthreads();
    if (threadIdx.x == 0) {
        unsigned* bar = b.bar;
        __builtin_amdgcn_s_waitcnt(0);
        unsigned nloc = b.st[0], nx = b.st[1];
        if (nloc == 0u) { xcd_barrier_complete(bar, b.x, nloc, nx); b.st[0] = nloc; b.st[1] = nx; }
        const unsigned old = xb_add(&bar[XB_XSUB(b.x)], 1u);
        const unsigned gen = old / nloc;
        if (old + 1u == (gen + 1u) * nloc) {
            __builtin_amdgcn_fence(__ATOMIC_RELEASE, "agent");
            asm volatile("s_waitcnt vmcnt(0)" ::: "memory");
            const unsigned og = xb_add(&bar[XB_TOP], 1u);
            const unsigned tg = og / nx;
            if (og + 1u == (tg + 1u) * nx) xb_add(&bar[XB_TOPGEN], 1u);
            else XB_SPIN(xb_ld(&bar[XB_TOPGEN]) == tg, bar);
            __builtin_amdgcn_fence(__ATOMIC_ACQUIRE, "agent");
            xb_add(&bar[XB_XGEN(b.x)], 1u);
            asm volatile("s_waitcnt vmcnt(0)" ::: "memory");
        } else {
            XB_SPIN(xb_ld(&bar[XB_XGEN(b.x)]) == gen, bar);
            __builtin_amdgcn_fence(__ATOMIC_ACQUIRE, "agent");
            asm volatile("s_waitcnt vmcnt(0)" ::: "memory");
        }
    }
    __syncthreads();
}

constexpr int NB = 2, SEQ = 8192, D = 1024, T = NB * SEQ;
constexpr int INC = 6416, NPROJ = 6400, DFF = 2816;
constexpr float EPS = 1e-6f;
constexpr size_t MiB = 1u << 20;
constexpr size_t WS_SSQ = 0;
constexpr size_t WS_XSLOT = 256 * 1024;
constexpr size_t WS_BAR = 512 * 1024;
constexpr size_t WS_ADEC = 1 * MiB;
constexpr size_t WS_KM = 1 * MiB + 512 * 1024;
constexpr size_t WS_VMT = 1 * MiB + 768 * 1024;
constexpr size_t WS_MN = 2 * MiB;
constexpr size_t WS_WALR = 3 * MiB;
constexpr size_t WS_WIN = 4 * MiB;
constexpr size_t WS_WAO = 17 * MiB, WS_WGO = 19 * MiB, WS_WMIX = 21 * MiB, WS_WMKV = 23 * MiB;
constexpr size_t WS_H = 24 * MiB;
constexpr size_t WS_QA = 56 * MiB;
constexpr size_t WS_QM = 56 * MiB, WS_OM = 64 * MiB;
constexpr size_t WS_KA = 88 * MiB, WS_VTA = 92 * MiB, WS_QG = 96 * MiB, WS_KG = 112 * MiB;
constexpr size_t WS_OG = 88 * MiB;
constexpr size_t WS_MERGED = 56 * MiB;
constexpr size_t WS_VTG = 128 * MiB;
constexpr size_t WS_WGU = 128 * MiB, WS_WD = 139 * MiB;
constexpr size_t WS_WMQ = 16 * MiB + 512 * 1024, WS_WMO = 3 * MiB + 256 * 1024;
constexpr size_t WS_GG = 160 * MiB;
constexpr size_t WS_ACT = 160 * MiB;
constexpr size_t WS_GT = 192 * MiB;
constexpr int LDS_BYTES = 152576 + 64, MISC_OFF = 152576;
constexpr int NPH = 13;

__device__ __forceinline__ float wave_sum(float v) {
#pragma unroll
    for (int o = 1; o < 64; o <<= 1) v += __shfl_xor(v, o);
    return v;
}
__device__ __forceinline__ float dot4(f32x4 a) { return (a[0] * a[0] + a[1] * a[1]) + (a[2] * a[2] + a[3] * a[3]); }
__device__ __forceinline__ float bf2f(unsigned short u) { return __uint_as_float((unsigned)u << 16); }

__device__ __forceinline__ void transpose_item(const float* W, int ldw, int col0, int k0, bf16* WT, int K, int drow0, const float* ksc, LAS float* scr, int lane) {
    float tv[32];
#pragma unroll
    for (int i = 0; i < 32; ++i) { const int kk = 2 * i + (lane >> 5); tv[i] = W[(size_t)(k0 + kk) * ldw + col0 + (lane & 31)]; }
    if (ksc) {
#pragma unroll
        for (int i = 0; i < 32; ++i) tv[i] *= ksc[k0 + 2 * i + (lane >> 5)];
    }
#pragma unroll
    for (int i = 0; i < 32; ++i) { const int kk = 2 * i + (lane >> 5); scr[kk * 33 + (lane & 31)] = tv[i]; }
    LDS_WAIT(); asm volatile("" ::: "memory");
    const int c = lane & 7;
#pragma unroll
    for (int j = 0; j < 4; ++j) { const int n = (lane >> 3) + 8 * j; const LAS float* s = scr + (8 * c) * 33 + n;
        v4u o; o.x = cvtpk(s[0 * 33], s[1 * 33]); o.y = cvtpk(s[2 * 33], s[3 * 33]); o.z = cvtpk(s[4 * 33], s[5 * 33]); o.w = cvtpk(s[6 * 33], s[7 * 33]);
        *(v4u*)(WT + (size_t)(drow0 + n) * K + k0 + 8 * c) = o; }
    LDS_WAIT(); asm volatile("" ::: "memory");
}
__device__ __forceinline__ void rms_row_bf16(const float* xrow, const float* w, bf16* orow, int lane) {
    const f32x4* xr = (const f32x4*)xrow + lane; const f32x4* wr = (const f32x4*)w + lane;
    f32x4 v[4]; float s = 0.f;
#pragma unroll
    for (int j = 0; j < 4; ++j) { v[j] = xr[64 * j]; s += dot4(v[j]); }
    const float rstd = 1.f / sqrtf(wave_sum(s) * (1.f / 1024.f) + EPS);
    v2u* o8 = (v2u*)orow + lane;
#pragma unroll
    for (int j = 0; j < 4; ++j) { const f32x4 y = v[j] * rstd * wr[64 * j]; v2u o; o.x = cvtpk(y[0], y[1]); o.y = cvtpk(y[2], y[3]); o8[64 * j] = o; }
}

__device__ __forceinline__ void rms_row2_bf16(const float* x0, const float* x1, const float* w, bf16* o0, bf16* o1, int lane) {
    const f32x4* xa = (const f32x4*)x0 + lane; const f32x4* xb = (const f32x4*)x1 + lane; const f32x4* wr = (const f32x4*)w + lane;
    f32x4 a[4], b[4]; float sa = 0.f, sb = 0.f;
#pragma unroll
    for (int j = 0; j < 4; ++j) { a[j] = xa[64 * j]; b[j] = xb[64 * j]; }
#pragma unroll
    for (int j = 0; j < 4; ++j) { sa += dot4(a[j]); sb += dot4(b[j]); }
#pragma unroll
    for (int o = 1; o < 64; o <<= 1) { sa += __shfl_xor(sa, o); sb += __shfl_xor(sb, o); }
    const float ra = 1.f / sqrtf(sa * (1.f / 1024.f) + EPS), rb = 1.f / sqrtf(sb * (1.f / 1024.f) + EPS);
    v2u* pa = (v2u*)o0 + lane; v2u* pb = (v2u*)o1 + lane;
#pragma unroll
    for (int j = 0; j < 4; ++j) { const f32x4 ww = wr[64 * j]; const f32x4 ya = a[j] * ra * ww, yb = b[j] * rb * ww; v2u oa, ob; oa.x = cvtpk(ya[0], ya[1]); oa.y = cvtpk(ya[2], ya[3]); ob.x = cvtpk(yb[0], yb[1]); ob.y = cvtpk(yb[2], yb[3]); pa[64 * j] = oa; pb[64 * j] = ob; }
}

__device__ __forceinline__ void rms_row4_bf16(const float* x0, size_t rstride, const float* w, bf16* o0, int lane) {
    const f32x4* wr = (const f32x4*)w + lane;
    f32x4 a[4][4]; float sa[4] = {0.f, 0.f, 0.f, 0.f};
#pragma unroll
    for (int u = 0; u < 4; ++u) { const f32x4* xa = (const f32x4*)(x0 + u * rstride) + lane;
#pragma unroll
        for (int j = 0; j < 4; ++j) a[u][j] = xa[64 * j]; }
#pragma unroll
    for (int u = 0; u < 4; ++u)
#pragma unroll
        for (int j = 0; j < 4; ++j) sa[u] += dot4(a[u][j]);
#pragma unroll
    for (int o = 1; o < 64; o <<= 1) {
#pragma unroll
        for (int u = 0; u < 4; ++u) sa[u] += __shfl_xor(sa[u], o); }
#pragma unroll
    for (int u = 0; u < 4; ++u) { const float ra = 1.f / sqrtf(sa[u] * (1.f / 1024.f) + EPS); v2u* pa = (v2u*)(o0 + u * rstride) + lane;
#pragma unroll
        for (int j = 0; j < 4; ++j) { const f32x4 ya = a[u][j] * ra * wr[64 * j]; v2u oa; oa.x = cvtpk(ya[0], ya[1]); oa.y = cvtpk(ya[2], ya[3]); pa[64 * j] = oa; } }
}

__device__ __forceinline__ void gla_prep(int ch, const bf16* H, const bf16* WalrT, const float* W2, const float* B2, const bf16* KG, bf16* KD, float* Adec, LAS unsigned char* lds, int tid) {
    const int lane = tid & 63, w = tid >> 6, l16 = lane & 15, quad = lane >> 4;
    LAS float* red = (LAS float*)lds;
    LAS float* alr = (LAS float*)(lds + 32768);
    unsigned short kraw[64];
    { const bf16* kin0 = KG + (size_t)ch * 32768 + tid;
#pragma unroll
      for (int t = 0; t < 64; ++t) kraw[t] = kin0[t * 512]; }
    f32x4 acc[4];
#pragma unroll
    for (int mt = 0; mt < 4; ++mt) acc[mt] = (f32x4){0.f, 0.f, 0.f, 0.f};
#pragma unroll
    for (int ks = 0; ks < 4; ++ks) {
        const int k0 = 128 * w + 32 * ks + 8 * quad;
        const bf16x8 bfr = *(const bf16x8*)(WalrT + l16 * 1024 + k0);
#pragma unroll
        for (int mt = 0; mt < 4; ++mt) { const bf16x8 afr = *(const bf16x8*)(H + (size_t)(ch * 64 + 16 * mt + l16) * 1024 + k0); acc[mt] = MFMA16(afr, bfr, acc[mt]); }
    }
#pragma unroll
    for (int mt = 0; mt < 4; ++mt)
#pragma unroll
        for (int j = 0; j < 4; ++j) red[(w * 64 + 16 * mt + 4 * quad + j) * 16 + l16] = acc[mt][j];
    __syncthreads();
    for (int e = tid; e < 1024; e += 512) { float s = 0.f;
#pragma unroll
        for (int w2 = 0; w2 < 8; ++w2) s += red[w2 * 1024 + e];
        alr[e] = s; }
    __syncthreads();
    const int f = tid;
    float w2r[16];
#pragma unroll
    for (int r = 0; r < 16; ++r) w2r[r] = W2[r * 512 + f];
    const float bb = B2[f];
    float bc[64]; float run = 0.f;
#pragma unroll
    for (int t = 0; t < 64; ++t) {
        float z = bb;
#pragma unroll
        for (int r4 = 0; r4 < 4; ++r4) { const f32x4 a = *(const LAS f32x4*)(alr + t * 16 + 4 * r4); z += a[0] * w2r[4 * r4] + a[1] * w2r[4 * r4 + 1] + a[2] * w2r[4 * r4 + 2] + a[3] * w2r[4 * r4 + 3]; }
        const float ls = fminf(z, 0.f) - __logf(1.f + __expf(-fabsf(z)));
        run += ls * (1.f / 16.f); bc[t] = run;
    }
    const float bend = run;
    unsigned pk[32];
#pragma unroll
    for (int t2 = 0; t2 < 32; ++t2) { const float k0 = bf2f(kraw[2 * t2]), k1 = bf2f(kraw[2 * t2 + 1]);
        pk[t2] = cvtpk(k0 * __expf(bend - bc[2 * t2]), k1 * __expf(bend - bc[2 * t2 + 1])); }
    __syncthreads();
    v4u* dst = (v4u*)(KD + (size_t)ch * 32768 + f * 64);
#pragma unroll
    for (int i = 0; i < 8; ++i) dst[i] = (v4u){pk[4 * i], pk[4 * i + 1], pk[4 * i + 2], pk[4 * i + 3]};
    Adec[(size_t)ch * 512 + f] = __expf(bend);
    __syncthreads();
}

__device__ __forceinline__ bf16x8 pack8(const f32x16& x, const int s, const float sc) {
    v4u p; p.x = cvtpk(x[8 * s] * sc, x[8 * s + 1] * sc); p.y = cvtpk(x[8 * s + 2] * sc, x[8 * s + 3] * sc); p.z = cvtpk(x[8 * s + 4] * sc, x[8 * s + 5] * sc); p.w = cvtpk(x[8 * s + 6] * sc, x[8 * s + 7] * sc);
    return __builtin_bit_cast(bf16x8, p);
}
template <int NKT, bool SINK>
__device__ __forceinline__ void attend32(const bf16* qp, const bf16* kbase, ptrdiff_t koff, int kpitch, const bf16* vbase, ptrdiff_t voff, int vpitch, int nskip, float scale, float sink, bf16* op, int opitch, int lane) {
    asm volatile("" : "+v"(lane));
    const int r = lane & 31, hh = lane >> 5;
    bf16x8 qf[4];
#pragma unroll
    for (int s = 0; s < 4; ++s) qf[s] = *(const bf16x8*)(qp + 16 * s + 8 * hh);
    float m = -3.0e38f;
#pragma unroll
    for (int kt = 0; kt < NKT; ++kt) {
        const int kte = kt < nskip ? nskip : kt;
        const bf16* kr = kbase + (koff + (ptrdiff_t)(32 * kte + r) * kpitch + 8 * hh);
        f32x16 a;
#pragma unroll
        for (int i = 0; i < 16; ++i) a[i] = 0.f;
#pragma unroll
        for (int s = 0; s < 4; ++s) a = MFMA32(*(const bf16x8*)(kr + 16 * s), qf[s], a);
        float mt = a[0];
#pragma unroll
        for (int i = 1; i < 16; ++i) mt = fmaxf(mt, a[i]);
        m = fmaxf(m, (kt < nskip) ? -1e30f : mt * scale);
        asm volatile("" ::: "memory");
    }
    m = fmaxf(m, __shfl_xor(m, 32));
    if (SINK) m = fmaxf(m, sink);
    float l = 0.f;
    f32x16 Z[2];
#pragma unroll
    for (int i = 0; i < 16; ++i) { Z[0][i] = 0.f; Z[1][i] = 0.f; }
#pragma unroll
    for (int kt = 0; kt < NKT; ++kt) {
        const int kte = kt < nskip ? nskip : kt;
        const bf16* kr = kbase + (koff + (ptrdiff_t)(32 * kte + r) * kpitch + 8 * hh);
        f32x16 a;
#pragma unroll
        for (int i = 0; i < 16; ++i) a[i] = 0.f;
#pragma unroll
        for (int s = 0; s < 4; ++s) a = MFMA32(*(const bf16x8*)(kr + 16 * s), qf[s], a);
#pragma unroll
        for (int i = 0; i < 16; ++i) { const float p = (kt < nskip) ? 0.f : __expf(a[i] * scale - m); a[i] = p; l += p; }
#pragma unroll
        for (int s = 0; s < 2; ++s) {
            const bf16x8 pa = pack8(a, s, 1.f);
#pragma unroll
            for (int nt = 0; nt < 2; ++nt) {
                const bf16* vr = vbase + (voff + (ptrdiff_t)(32 * nt + r) * vpitch + 32 * kte + 16 * s + 4 * hh);
                const s16x4 lo = *(const s16x4*)vr, hi = *(const s16x4*)(vr + 8);
                const bf16x8 bv = __builtin_shufflevector(lo, hi, 0, 1, 2, 3, 4, 5, 6, 7);
                Z[nt] = MFMA32(pa, bv, Z[nt]);
            }
        }
        asm volatile("" ::: "memory");
    }
    l += __shfl_xor(l, 32);
    if (SINK) l += __expf(sink - m);
    const float inv = 1.f / l;
#pragma unroll
    for (int i = 0; i < 16; ++i) { const int qq = (i & 3) + 8 * (i >> 2) + 4 * hh; const float iq = __shfl(inv, qq);
        op[(size_t)qq * opitch + r] = (bf16)(cvtpk(Z[0][i] * iq, 0.f) & 0xffffu); op[(size_t)qq * opitch + 32 + r] = (bf16)(cvtpk(Z[1][i] * iq, 0.f) & 0xffffu); }
}

#define GLDS16(gp, lp) __builtin_amdgcn_global_load_lds((const unsigned*)(gp), (LAS unsigned*)(lp), 16, 0, 0)
#define WAITV(n) asm volatile("s_waitcnt vmcnt(" #n ")" ::: "memory")
#define RAWBAR() do { asm volatile("s_waitcnt lgkmcnt(0)" ::: "memory"); __builtin_amdgcn_s_barrier(); asm volatile("" ::: "memory"); } while (0)
constexpr int GS_KD = 0, GS_V = 16384, GS_A = 20480, GS_KDV = 21504, GS_QR = 3 * GS_KDV, GS_QS = 16384, GS_SX = GS_QR + 4 * GS_QS, GS_SXP = 272, GS_SXB = 32 * GS_SXP;
#define GLA_ISSUE_KDV(cc, slot) do { LAS unsigned char* sb_ = lds + (slot) * GS_KDV; const size_t cho_ = (size_t)(b * 128 + (cc)) * 32768; \
    _Pragma("unroll") for (int i_ = 0; i_ < 4; ++i_) GLDS16(KdT + cho_ + okd[i_], sb_ + GS_KD + (4 * w + i_) * 1024); \
    GLDS16(vbase + ov + (cc) * 64, sb_ + GS_V + w * 1024); \
    if (w == 0) GLDS16(abase + (size_t)(cc) * 512, sb_ + GS_A); } while (0)
#define GLA_ISSUE_Q(cc, slot) do { LAS unsigned char* sb_ = lds + GS_QR + (slot) * GS_QS; const size_t cho_ = (size_t)(b * 128 + (cc)) * 32768; \
    _Pragma("unroll") for (int i_ = 0; i_ < 4; ++i_) GLDS16(QG + cho_ + oq[i_], sb_ + (4 * w + i_) * 1024); } while (0)
template <int ABL>
__device__ __forceinline__ void gla_scan(int b, int h, int vs, const bf16* KdT, const float* Adec, const bf16* VTg, const bf16* QG, bf16* ORAW, LAS unsigned char* lds, int tid) {
    const int lane = tid & 63, w = __builtin_amdgcn_readfirstlane(tid >> 6), wk = w & 3, r = lane & 31, hh = lane >> 5, l16 = lane & 15, quad = lane >> 4;
    unsigned okd[4], oq[4], ov;
#pragma unroll
    for (int i = 0; i < 4; ++i) { const int row = 32 * wk + 8 * i + (lane >> 3), lch = (lane & 7) ^ ((row >> 1) & 7); okd[i] = (unsigned)((h * 128 + row) * 64 + lch * 8); }
#pragma unroll
    for (int i = 0; i < 4; ++i) { const int row = 16 * wk + 4 * i + (lane >> 4), lch = (lane & 15) ^ (row & 15); oq[i] = (unsigned)(row * 512 + h * 128 + lch * 8); }
    { const int row = 8 * wk + (lane >> 3), lch = (lane & 7) ^ ((row >> 1) & 7); ov = (unsigned)((vs * 32 + row) * 8192 + lch * 8); }
    const bf16* vbase = VTg + (size_t)(b * 1024 + h * 256) * 8192;
    const float* abase = Adec + (size_t)(b * 128) * 512 + (h & ~1) * 128 + 4 * lane;
    int rkd[4], rv[4], rq[4];
#pragma unroll
    for (int s = 0; s < 4; ++s) { const int rowk = 32 * wk + r, rowv = r;
        rkd[s] = rowk * 128 + (((2 * s + hh) ^ ((rowk >> 1) & 7)) * 16); rv[s] = rowv * 128 + (((2 * s + hh) ^ ((rowv >> 1) & 7)) * 16); }
    const int jt = w & 3;
#pragma unroll
    for (int ks = 0; ks < 4; ++ks) { const int rowq = 16 * jt + l16; rq[ks] = rowq * 256 + (((4 * ks + quad) ^ (rowq & 15)) * 16); }
    const int aoff = ((h & 1) * 128 + 32 * wk + 4 * hh) * 4;
    const int sxw = r * GS_SXP + (32 * wk + 4 * hh) * 2;
    const int sxr = l16 * GS_SXP + 16 * quad;
    f32x16 S;
#pragma unroll
    for (int i = 0; i < 16; ++i) S[i] = 0.f;
    if (w < 4) { GLA_ISSUE_KDV(0, 0); GLA_ISSUE_Q(0, 0); GLA_ISSUE_KDV(1, 1); GLA_ISSUE_Q(1, 1); }
    int sk = 0, sq = 0;
    for (int i = 0; i <= 128; ++i) {
        if (w < 4) { if (i < 126) { if (w == 0) WAITV(14); else WAITV(13); } else WAITV(0); }
        RAWBAR();
        if (w < 4) {
            if (i < 128) {
                LAS unsigned char* sb = lds + sk * GS_KDV;
                bf16x8 ka[4], vb[4]; f32x4 a4[4];
                ka[2] = *(const LAS bf16x8*)(sb + GS_KD + rkd[2]); vb[2] = *(const LAS bf16x8*)(sb + GS_V + rv[2]);
                ka[3] = *(const LAS bf16x8*)(sb + GS_KD + rkd[3]); vb[3] = *(const LAS bf16x8*)(sb + GS_V + rv[3]);
#pragma unroll
                for (int q = 0; q < 4; ++q) a4[q] = *(const LAS f32x4*)(sb + GS_A + aoff + 32 * q);
                ka[0] = *(const LAS bf16x8*)(sb + GS_KD + rkd[0]); vb[0] = *(const LAS bf16x8*)(sb + GS_V + rv[0]);
                ka[1] = *(const LAS bf16x8*)(sb + GS_KD + rkd[1]); vb[1] = *(const LAS bf16x8*)(sb + GS_V + rv[1]);
                f32x16 U;
#pragma unroll
                for (int ii = 0; ii < 16; ++ii) U[ii] = 0.f;
                U = MFMA32(ka[2], vb[2], U); U = MFMA32(ka[3], vb[3], U);
#pragma unroll
                for (int ii = 0; ii < 16; ++ii) S[ii] *= a4[ii >> 2][ii & 3];
                S = MFMA32(ka[0], vb[0], S); S = MFMA32(ka[1], vb[1], S);
                __builtin_amdgcn_sched_barrier(0);
                if (i + 2 < 128) { const int s2 = sk == 0 ? 2 : sk - 1; GLA_ISSUE_KDV(i + 2, s2); }
                __builtin_amdgcn_sched_barrier(0);
#pragma unroll
                for (int ii = 0; ii < 16; ++ii) S[ii] += U[ii];
                LAS unsigned char* sxb = lds + GS_SX + (i & 1) * GS_SXB;
#pragma unroll
                for (int q = 0; q < 4; ++q) { v2u pkd; pkd.x = cvtpk(S[4 * q], S[4 * q + 1]); pkd.y = cvtpk(S[4 * q + 2], S[4 * q + 3]); *(LAS v2u*)(sxb + sxw + 16 * q) = pkd; }
                if (i + 2 < 128) { const int q2 = (i + 2) & 3; GLA_ISSUE_Q(i + 2, q2); }
            }
        } else if (i >= 1) {
            const int c = i - 1;
            const LAS unsigned char* qb = lds + GS_QR + (c & 3) * GS_QS;
            const LAS unsigned char* sxb = lds + GS_SX + (c & 1) * GS_SXB;
            bf16x8 qa[4];
#pragma unroll
            for (int ks = 0; ks < 4; ++ks) qa[ks] = *(const LAS bf16x8*)(qb + rq[ks]);
            bf16* orow = ORAW + ((size_t)((b * 128 + c) * 64 + 16 * jt + 4 * quad)) * 1024 + h * 256 + vs * 32 + l16;
#pragma unroll
            for (int vt = 0; vt < 2; ++vt) {
                f32x4 o = {0.f, 0.f, 0.f, 0.f};
#pragma unroll
                for (int ks = 0; ks < 4; ++ks) o = MFMA16(qa[ks], *(const LAS bf16x8*)(sxb + vt * 16 * GS_SXP + sxr + 64 * ks), o);
#pragma unroll
                for (int j = 0; j < 4; ++j) { if (!(ABL & 1)) orow[(size_t)j * 1024 + 16 * vt] = (bf16)(cvtpk(o[j] * 0.08838834764831845f, 0.f) & 0xffffu); else asm volatile("" :: "v"(o[j])); }
            }
        }
        sk = sk == 2 ? 0 : sk + 1;
    }
    WAITV(0); RAWBAR();
}
constexpr int SW_KP = 144, SW_VP = 400, SW_V0 = 192 * SW_KP, SW_BUF = SW_V0 + 64 * SW_VP;
__device__ __forceinline__ void swa_fetch(int js, const bf16* KA, const bf16* VTA, int tid, v4u (&kr)[3], v4u (&vr)[3]) {
    const int b = js >> 8, c = (js >> 1) & 127, g = js & 1, nsk = c < 2 ? 64 * (2 - c) : 0;
    const ptrdiff_t krow0 = (ptrdiff_t)b * 8192 + (c - 2) * 64;
#pragma unroll
    for (int i = 0; i < 3; ++i) { const int p = tid + 512 * i, row = p >> 3, ch = p & 7;
        kr[i] = (row >= nsk) ? *(const v4u*)(KA + (krow0 + row) * 128 + g * 64 + ch * 8) : (v4u){0u, 0u, 0u, 0u}; }
#pragma unroll
    for (int i = 0; i < 3; ++i) { const int p = tid + 512 * i, d = p / 24, ch = p - 24 * d;
        vr[i] = (ch * 8 >= nsk) ? *(const v4u*)(VTA + ((ptrdiff_t)(b * 128 + g * 64 + d)) * 8192 + (c - 2) * 64 + ch * 8) : (v4u){0u, 0u, 0u, 0u}; }
}
__device__ __forceinline__ void swa_stash(LAS unsigned char* buf, int tid, const v4u (&kr)[3], const v4u (&vr)[3]) {
#pragma unroll
    for (int i = 0; i < 3; ++i) { const int p = tid + 512 * i, row = p >> 3, ch = p & 7; *(LAS v4u*)(buf + row * SW_KP + ch * 16) = kr[i]; }
#pragma unroll
    for (int i = 0; i < 3; ++i) { const int p = tid + 512 * i, d = p / 24, ch = p - 24 * d; *(LAS v4u*)(buf + SW_V0 + d * SW_VP + ch * 16) = vr[i]; }
}
template <int NKT, int KP, int VP, int OP, bool SINK>
__device__ __forceinline__ void lds_attend(const bf16* qp, const LAS unsigned char* Ks, const LAS unsigned char* Vts, int nskip, float scale, float sink, bf16* op, int lane) {
    asm volatile("" : "+v"(lane));
    const int r = lane & 31, hh = lane >> 5;
    bf16x8 qf[4];
#pragma unroll
    for (int s = 0; s < 4; ++s) qf[s] = *(const bf16x8*)(qp + 16 * s + 8 * hh);
    const LAS unsigned char* kl = Ks + r * KP + 16 * hh;
    float m = -3.0e38f;
#pragma unroll
    for (int kt = 0; kt < NKT; ++kt) {
        if (kt >= nskip) {
            f32x16 a;
#pragma unroll
            for (int i = 0; i < 16; ++i) a[i] = 0.f;
#pragma unroll
            for (int s = 0; s < 4; ++s) a = MFMA32(*(const LAS bf16x8*)(kl + kt * 32 * KP + 32 * s), qf[s], a);
            float mt = a[0];
#pragma unroll
            for (int i = 1; i < 16; ++i) mt = fmaxf(mt, a[i]);
            m = fmaxf(m, mt * scale);
        }
        asm volatile("" ::: "memory");
    }
    m = fmaxf(m, __shfl_xor(m, 32));
    if (SINK) m = fmaxf(m, sink);
    float l = 0.f;
    f32x16 Z[2];
#pragma unroll
    for (int i = 0; i < 16; ++i) { Z[0][i] = 0.f; Z[1][i] = 0.f; }
    const LAS unsigned char* vl = Vts + r * VP + 8 * hh;
#pragma unroll
    for (int kt = 0; kt < NKT; ++kt) {
        if (kt >= nskip) {
            f32x16 a;
#pragma unroll
            for (int i = 0; i < 16; ++i) a[i] = 0.f;
#pragma unroll
            for (int s = 0; s < 4; ++s) a = MFMA32(*(const LAS bf16x8*)(kl + kt * 32 * KP + 32 * s), qf[s], a);
#pragma unroll
            for (int i = 0; i < 16; ++i) { const float p = __expf(a[i] * scale - m); a[i] = p; l += p; }
#pragma unroll
            for (int s = 0; s < 2; ++s) {
                const bf16x8 pa = pack8(a, s, 1.f);
#pragma unroll
                for (int nt = 0; nt < 2; ++nt) {
                    const LAS unsigned char* vp = vl + nt * 32 * VP + (32 * kt + 16 * s) * 2;
                    const s16x4 lo = *(const LAS s16x4*)vp, hi = *(const LAS s16x4*)(vp + 16);
                    const bf16x8 bv = __builtin_shufflevector(lo, hi, 0, 1, 2, 3, 4, 5, 6, 7);
                    Z[nt] = MFMA32(pa, bv, Z[nt]);
                }
            }
        }
        asm volatile("" ::: "memory");
    }
    l += __shfl_xor(l, 32);
    if (SINK) l += __expf(sink - m);
    const float inv = 1.f / l;
#pragma unroll
    for (int i = 0; i < 16; ++i) { const int qq = (i & 3) + 8 * (i >> 2) + 4 * hh; const float iq = __shfl(inv, qq);
        op[(size_t)qq * OP + r] = (bf16)(cvtpk(Z[0][i] * iq, 0.f) & 0xffffu); op[(size_t)qq * OP + 32 + r] = (bf16)(cvtpk(Z[1][i] * iq, 0.f) & 0xffffu); }
}
__device__ __forceinline__ void swa_phase(int j0, int jstride, int njobs, const bf16* QA, bf16* OA, const bf16* KA, const bf16* VTA, const float* sinks, LAS unsigned char* lds, int tid) {
    asm volatile("" : "+v"(tid));
    const int lane = tid & 63, wave = __builtin_amdgcn_readfirstlane(tid >> 6);
    if (j0 >= njobs) return;
    v4u kr[3], vr[3];
    swa_fetch(j0, KA, VTA, tid, kr, vr);
    swa_stash(lds, tid, kr, vr);
    __syncthreads();
    int buf = 0;
    for (int js = j0; js < njobs; js += jstride) {
        const int jn = js + jstride; const bool more = jn < njobs;
        if (more) swa_fetch(jn, KA, VTA, tid, kr, vr);
        const int b = js >> 8, c = (js >> 1) & 127, g = js & 1, hq = 8 * g + wave;
        const int nskip = c < 2 ? 2 * (2 - c) : 0;
        const size_t trow0 = (size_t)b * 8192 + c * 64;
        const float sk = sinks[hq];
        const LAS unsigned char* Ks = lds + buf * SW_BUF;
#pragma unroll 1
        for (int qg = 0; qg < 2; ++qg)
            lds_attend<6, SW_KP, SW_VP, 1024, true>(QA + (trow0 + 32 * qg + (lane & 31)) * 1024 + hq * 64, Ks, Ks + SW_V0, nskip, 0.125f, sk, OA + (trow0 + 32 * qg) * 1024 + hq * 64, lane);
        if (more) swa_stash(lds + (buf ^ 1) * SW_BUF, tid, kr, vr);
        __syncthreads();
        buf ^= 1;
    }
}
__device__ __forceinline__ void sub_barrier(unsigned* ctr, unsigned n) {
    asm volatile("s_waitcnt vmcnt(0)" ::: "memory");
    __syncthreads();
    if (threadIdx.x == 0) {
        __builtin_amdgcn_fence(__ATOMIC_RELEASE, "agent"); asm volatile("s_waitcnt vmcnt(0)" ::: "memory");
        __hip_atomic_fetch_add(ctr, 1u, __ATOMIC_RELAXED, __HIP_MEMORY_SCOPE_AGENT);
        unsigned sp = 0;
        while (__hip_atomic_load(ctr, __ATOMIC_RELAXED, __HIP_MEMORY_SCOPE_AGENT) < n) { __builtin_amdgcn_s_sleep(2); if (++sp > (1u << 24)) break; }
        __builtin_amdgcn_fence(__ATOMIC_ACQUIRE, "agent"); asm volatile("s_waitcnt vmcnt(0)" ::: "memory");
    }
    __syncthreads();
}
struct Args { const float* in[22]; float* out; unsigned char* ws; int ph_lo, ph_hi, dry, pad; };
#ifndef MK_N_LAUNCHES
#define MK_N_LAUNCHES 1
#endif

#define X_IN (args.in[0])
#define MEM_IN (args.in[1])
#define norm_mix_w (args.in[2])
#define w_in (args.in[3])
#define b_gate (args.in[4])
#define sinks (args.in[5])
#define gate_w2 (args.in[6])
#define gate_b (args.in[7])
#define gla_norm_w (args.in[8])
#define w_attn_o (args.in[9])
#define w_gla_o (args.in[10])
#define w_mix_o (args.in[11])
#define norm_mem_q_w (args.in[12])
#define norm_mem_kv_w (args.in[13])
#define w_mem_q (args.in[14])
#define w_mem_kv (args.in[15])
#define w_mem_o (args.in[16])
#define norm_ffn_w (args.in[17])
#define w_ffn_gate (args.in[18])
#define w_ffn_up (args.in[19])
#define w_ffn_down (args.in[20])
#define norm_final_w (args.in[21])
#define OUT_P (args.out)
#define WSB(off) ((bf16*)(args.ws + (off)))
#define SSQ1 ((float*)(args.ws + WS_SSQ))
#define SSQ2 (SSQ1 + T)
#define SSQ3 (SSQ1 + 2 * T)
#define ADEC ((float*)(args.ws + WS_ADEC))
#define KM WSB(WS_KM)
#define VMT WSB(WS_VMT)
#define MN WSB(WS_MN)
#define WALR WSB(WS_WALR)
#define WIN WSB(WS_WIN)
#define WAO WSB(WS_WAO)
#define WGO WSB(WS_WGO)
#define WMIX WSB(WS_WMIX)
#define WMKV WSB(WS_WMKV)
#define HB WSB(WS_H)
#define QA WSB(WS_QA)
#define QM WSB(WS_QM)
#define OM WSB(WS_OM)
#define KA WSB(WS_KA)
#define VTA WSB(WS_VTA)
#define QG WSB(WS_QG)
#define KG WSB(WS_KG)
#define MERGED WSB(WS_MERGED)
#define OGB WSB(WS_OG)
#define VTG WSB(WS_VTG)
#define WGU WSB(WS_WGU)
#define WD WSB(WS_WD)
#define WMQ WSB(WS_WMQ)
#define WMO WSB(WS_WMO)
#define GG WSB(WS_GG)
#define ORAWB ((bf16*)OUT_P)
#define TMP ((bf16*)OUT_P + (size_t)T * 1024)
#define ACT WSB(WS_ACT)
#define GT WSB(WS_GT)
__global__ void __launch_bounds__(512, 2) mk_fwd(Args args) {
    extern __shared__ __attribute__((aligned(16))) unsigned char lds_raw[];
    LAS unsigned char* lds = (LAS unsigned char*)lds_raw;
    const int tid = threadIdx.x, lane = tid & 63, wave = __builtin_amdgcn_readfirstlane(tid >> 6);
    const int G = gridDim.x, bx = blockIdx.x;
    const int gw = bx * 8 + wave, NGW = G * 8;
    const int lo = args.ph_lo, hi = args.ph_hi;
#define IN(k) (lo <= (k) && (k) < hi)
#ifndef P10_ALIGN
#define P10_ALIGN true
#endif
#ifndef PHMASK
#define PHMASK 0xffff
#endif
#ifndef DUPPH
#define DUPPH -1
#endif
#define PHEN(k) (((PHMASK) >> (k)) & 1)
#define SEAM(k) do { if (IN(k) && IN((k) + 1)) { if ((k) == 0) cg::this_grid().sync(); else { XcdBarrier xb_; xb_.bar = (unsigned*)(args.ws + WS_BAR); xb_.x = xb_xcc_id(); xb_.st = MISC + 8; xcd_barrier(xb_); } } } while (0)
    LAS float* scr = (LAS float*)(lds + wave * 8448);
    volatile LAS unsigned* MISC = (volatile LAS unsigned*)(lds + MISC_OFF);
    if (tid < 16) MISC[tid] = 0u;
    __syncthreads();
    XcdBarrier xbar; xbar.bar = (unsigned*)(args.ws + WS_BAR); xbar.x = 0; xbar.st = nullptr;

    if (PHEN(0) && IN(0)) for (int rep_ = 0; rep_ < ((DUPPH == 0) ? 2 : 1); ++rep_) {
        constexpr int I_IN = 200 * 16, I_SQ = 32 * 16, I_KV = 16 * 16, I_MQ = 8 * 16, I_MO = 32 * 4, NIT = I_IN + 3 * I_SQ + I_KV + I_MQ + I_MO;
        for (int it = gw; it < NIT; it += NGW) {
            int r = it;
            if (r < I_IN) { const int nb = r % 200, kb = r / 200, n0 = 32 * nb; transpose_item(w_in, INC, n0 + (n0 >= 4352 ? 16 : 0), 64 * kb, WIN, 1024, n0, nullptr, scr, lane); continue; } r -= I_IN;
            if (r < I_SQ) { transpose_item(w_attn_o, 1024, 32 * (r & 31), 64 * (r >> 5), WAO, 1024, 32 * (r & 31), nullptr, scr, lane); continue; } r -= I_SQ;
            if (r < I_SQ) { transpose_item(w_gla_o, 1024, 32 * (r & 31), 64 * (r >> 5), WGO, 1024, 32 * (r & 31), nullptr, scr, lane); continue; } r -= I_SQ;
            if (r < I_SQ) { transpose_item(w_mix_o, 1024, 32 * (r & 31), 64 * (r >> 5), WMIX, 1024, 32 * (r & 31), nullptr, scr, lane); continue; } r -= I_SQ;
            if (r < I_KV) { transpose_item(w_mem_kv, 512, 32 * (r & 15), 64 * (r >> 4), WMKV, 1024, 32 * (r & 15), nullptr, scr, lane); continue; } r -= I_KV;
            if (r < I_MQ) { transpose_item(w_mem_q, 256, 32 * (r & 7), 64 * (r >> 3), WMQ, 1024, 32 * (r & 7), norm_mem_q_w, scr, lane); continue; } r -= I_MQ;
            transpose_item(w_mem_o, 1024, 32 * (r & 31), 64 * (r >> 5), WMO, 256, 32 * (r & 31), nullptr, scr, lane);
        }
        for (int e = bx * 512 + tid; e < 16 * 1024; e += G * 512) { const int r = e >> 10, k = e & 1023; WALR[e] = (bf16)(cvtpk(w_in[(size_t)k * INC + 4352 + r], 0.f) & 0xffffu); }
        for (int e = bx * 512 + tid; e < 3 * T; e += G * 512) SSQ1[e] = 0.f;
        for (int e = bx * 512 + tid; e < 8192; e += G * 512) ((unsigned*)(args.ws + WS_BAR))[e] = 0u;
        for (int m = gw; m < T; m += 4 * NGW) rms_row4_bf16(X_IN + (size_t)m * D, (size_t)NGW * D, norm_mix_w, HB + (size_t)m * D, lane);
        for (int m = gw; m < 512; m += NGW) rms_row_bf16(MEM_IN + (size_t)m * D, norm_mem_kv_w, MN + (size_t)m * D, lane);
    }
    SEAM(0);
    if (hi - lo > 1) (void)xcd_barrier_post((unsigned*)(args.ws + WS_BAR), MISC + 8);
    if (PHEN(1) && IN(1)) {
        pg8::Gemm g{HB, WIN, T, 6144, D}; pg8::StaticOrder S; S.init(T, 6144, G, bx);
        pg8::EpiProj E{QA, KA, VTA, QG, KG, VTG, GG, GT, b_gate};
        pg8::gemm_phase<pg8::EpiProj, pg8::StaticOrder, true, true>(lds, g, S, E);
    }
    SEAM(1);
    if (PHEN(2) && IN(2)) { int td2 = tid; asm volatile("" : "+v"(td2)); for (int ch = bx; ch < 256; ch += G) gla_prep(ch, HB, WALR, gate_w2, gate_b, KG, args.dry ? (bf16*)OUT_P : KG, args.dry ? OUT_P + 16 * 1024 * 1024 : ADEC, lds, td2); }
    SEAM(2);
    if (PHEN(3) && IN(3)) {
        constexpr int NGLA = 64, NSWA = 512;
        int ln3 = lane, td3 = tid; asm volatile("" : "+v"(ln3), "+v"(td3));
        if (bx < NGLA) { gla_scan<0>((bx >> 2) & 1, bx & 3, bx >> 3, KG, ADEC, VTG, QG, ORAWB, lds, td3);
#ifdef GLA_ABL
            gla_scan<GLA_ABL>((bx >> 2) & 1, bx & 3, bx >> 3, KG, ADEC, VTG, QG, ORAWB, lds, td3);
#endif
        }
        else {
            swa_phase(bx - NGLA, G - NGLA, NSWA, QA, args.dry ? HB : QA, KA, VTA, sinks, lds, td3);
            const int p = bx - NGLA;
            sub_barrier((unsigned*)(args.ws + WS_BAR + 14336), (unsigned)(G - NGLA));
            if (p < 64) {
                { pg8::Gemm g{HB, WIN, T, NPROJ, D}; pg8::OneUnit S{p, 24};
                  pg8::EpiProj E{QA, KA, VTA, QG, KG, VTG, GG, GT, b_gate};
                  pg8::gemm_phase<pg8::EpiProj, pg8::OneUnit, true, true>(lds, g, S, E); }
                if (p < 4) { pg8::Gemm g{MN, WMKV, 512, 512, D}; pg8::OneUnit S{p >> 1, p & 1};
                  pg8::EpiMemKV E{KM, VMT};
                  pg8::gemm_phase<pg8::EpiMemKV, pg8::OneUnit, true, true>(lds, g, S, E); }
            } else { pg8::Gemm g{QA, WAO, T, D, D}; pg8::StrideOrder S{p - 64, G - NGLA - 64, 256}; pg8::EpiGate E{GT, TMP, MERGED, 0};
              pg8::gemm_phase<pg8::EpiGate, pg8::StrideOrder, true, true>(lds, g, S, E);
            }
        }
    }
    SEAM(3);
    if (PHEN(4) && IN(4)) for (int rep_ = 0; rep_ < ((DUPPH == 4) ? 2 : 1); ++rep_) {
        const f32x4 w4 = *(const f32x4*)(gla_norm_w + 4 * lane);
        for (int it0 = gw; it0 < T * 4; it0 += 8 * NGW) {
            v2u ov[8], gv[8]; float ss[8];
#pragma unroll
            for (int u = 0; u < 8; ++u) { const size_t off = (size_t)(it0 + u * NGW) * 256 + 4 * lane; ov[u] = *(const v2u*)(ORAWB + off); gv[u] = *(const v2u*)(GG + off); }
#pragma unroll
            for (int u = 0; u < 8; ++u) { const f32x4 v = {__uint_as_float(ov[u].x << 16), __uint_as_float(ov[u].x & 0xffff0000u), __uint_as_float(ov[u].y << 16), __uint_as_float(ov[u].y & 0xffff0000u)}; ss[u] = dot4(v); }
#pragma unroll
            for (int o = 1; o < 64; o <<= 1) {
#pragma unroll
                for (int u = 0; u < 8; ++u) ss[u] += __shfl_xor(ss[u], o); }
#pragma unroll
            for (int u = 0; u < 8; ++u) { const size_t off = (size_t)(it0 + u * NGW) * 256 + 4 * lane;
                const float rstd = 1.f / sqrtf(ss[u] * (1.f / 256.f) + EPS);
                const f32x4 v = {__uint_as_float(ov[u].x << 16), __uint_as_float(ov[u].x & 0xffff0000u), __uint_as_float(ov[u].y << 16), __uint_as_float(ov[u].y & 0xffff0000u)};
                const f32x4 gr = {__uint_as_float(gv[u].x << 16), __uint_as_float(gv[u].x & 0xffff0000u), __uint_as_float(gv[u].y << 16), __uint_as_float(gv[u].y & 0xffff0000u)};
                const f32x4 sg = gr * pg8::sigm4(gr);
                const f32x4 y = v * rstd * w4 * sg;
                v2u o; o.x = cvtpk(y[0], y[1]); o.y = cvtpk(y[2], y[3]); *(v2u*)(OGB + off) = o; }
        }
    }
    SEAM(4);
    if (PHEN(5) && IN(5)) {
        pg8::StaticOrder S; S.init(T, D, G, bx);
        pg8::Gemm g{OGB, WGO, T, D, D}; pg8::EpiGate E{GT, TMP, MERGED, 1}; pg8::gemm_phase<pg8::EpiGate, pg8::StaticOrder, true, true>(lds, g, S, E);
    }
    SEAM(5);
    if (PHEN(6) && IN(6)) { pg8::Gemm g{MERGED, WMIX, T, D, D}; pg8::StaticOrder S; S.init(T, D, G, bx); pg8::EpiResid E{X_IN, nullptr, nullptr, args.dry ? GG : HB, args.dry ? SSQ3 : SSQ1};
        pg8::gemm_phase<pg8::EpiResid, pg8::StaticOrder, true, true>(lds, g, S, E); }
    SEAM(6);
    if (PHEN(7) && IN(7)) {
        { pg8::Gemm g{HB, WMQ, T, 256, D}; pg8::StaticOrder S; S.init(T, 256, G, bx); pg8::EpiScaleQ E{QM, SSQ1};
          pg8::gemm_phase<pg8::EpiScaleQ, pg8::StaticOrder, true, true>(lds, g, S, E); }
        if (bx >= 64 || G <= 64) {
            constexpr int I_GU = 176 * 16, I_D = 32 * 44, NIT = I_GU + I_D;
            const int gw7 = (G > 64 ? (bx - 64) : bx) * 8 + wave, ngw7 = (G > 64 ? (G - 64) : G) * 8;
            for (int it = gw7; it < NIT; it += ngw7) {
                int r = it;
                if (r < I_GU) { const int nb = r % 176, kb = r / 176, n0 = 32 * nb, pn = n0 >> 8, r0 = n0 & 255;
                    transpose_item(r0 < 128 ? w_ffn_gate : w_ffn_up, DFF, 128 * pn + (r0 & 127), 64 * kb, WGU, 1024, n0, norm_ffn_w, scr, lane); continue; } r -= I_GU;
                transpose_item(w_ffn_down, 1024, 32 * (r & 31), 64 * (r >> 5), WD, DFF, 32 * (r & 31), nullptr, scr, lane);
            }
        }
    }
    SEAM(7);
    if (PHEN(8) && IN(8)) for (int rep_ = 0; rep_ < ((DUPPH == 8) ? 2 : 1); ++rep_) {
        constexpr int XK = 144, XV = 528, XV0 = 256 * XK;
        int td8 = tid; asm volatile("" : "+v"(td8));
        for (int j = bx; j < 256; j += G) {
            const int hm = j & 3, qt = j >> 2, b = qt >> 5;
            v4u kr[4], vr[4];
#pragma unroll
            for (int i = 0; i < 4; ++i) { const int pc = td8 + 512 * i; kr[i] = *(const v4u*)(KM + (size_t)(b * 256 + (pc >> 3)) * 256 + hm * 64 + (pc & 7) * 8);
                vr[i] = *(const v4u*)(VMT + (size_t)(b * 256 + hm * 64 + (pc >> 5)) * 256 + (pc & 31) * 8); }
#pragma unroll
            for (int i = 0; i < 4; ++i) { const int pc = td8 + 512 * i; *(LAS v4u*)(lds + (pc >> 3) * XK + (pc & 7) * 16) = kr[i]; *(LAS v4u*)(lds + XV0 + (pc >> 5) * XV + (pc & 31) * 16) = vr[i]; }
            __syncthreads();
            const int q0 = qt * 256 + 32 * wave;
            lds_attend<8, XK, XV, 256, false>(QM + (size_t)(q0 + (td8 & 31)) * 256 + hm * 64, lds, lds + XV0, 0, 1.0f, 0.f, OM + (size_t)q0 * 256 + hm * 64, td8 & 63);
            __syncthreads();
        }
    }
    SEAM(8);
    if (PHEN(9) && IN(9)) { pg8::Gemm g{OM, WMO, T, D, 256}; pg8::StaticOrder S; S.init(T, D, G, bx); pg8::EpiResid E{nullptr, HB, nullptr, args.dry ? GG : HB, args.dry ? SSQ3 : SSQ2};
        pg8::gemm_phase<pg8::EpiResid, pg8::StaticOrder, true, true>(lds, g, S, E); }
    SEAM(9);
    if (PHEN(10) && IN(10)) for (int rep_ = 0; rep_ < ((DUPPH == 10) ? 2 : 1); ++rep_) { pg8::Gemm g{HB, WGU, T, 2 * DFF, D}; pg8::StaticOrder S; S.init(T, 2 * DFF, G, bx); pg8::EpiSwiglu E{ACT, SSQ2};
        pg8::gemm_phase<pg8::EpiSwiglu, pg8::StaticOrder, true, true>(lds, g, S, E); }
    SEAM(10);
    if (PHEN(11) && IN(11)) {
        pg8::Gemm g{ACT, WD, T, D, DFF}; pg8::StaticOrder S; S.init(T, D, G, bx);
        if (G == 256 && !args.dry) {
            pg8::EpiFinal E{HB, OUT_P, norm_final_w, (float*)(args.ws + WS_XSLOT), (unsigned*)(args.ws + WS_BAR + 16384)};
            pg8::gemm_phase<pg8::EpiFinal, pg8::StaticOrder, false, true>(lds, g, S, E);
        } else {
            pg8::EpiResid E{nullptr, HB, args.dry ? (float*)(args.ws + WS_QA) : OUT_P, nullptr, nullptr};
            pg8::gemm_phase<pg8::EpiResid, pg8::StaticOrder, true, true>(lds, g, S, E);
        }
    }
    if (G != 256 || args.dry) SEAM(11);
    if (PHEN(12) && IN(12) && (G != 256 || args.dry)) {
        const f32x4* wr = (const f32x4*)norm_final_w + lane;
        for (int m0 = gw; m0 < T; m0 += 4 * NGW) {
            f32x4 v[4][4]; float s[4] = {0.f, 0.f, 0.f, 0.f};
#pragma unroll
            for (int u = 0; u < 4; ++u) { const f32x4* xr = (const f32x4*)(OUT_P + (size_t)(m0 + u * NGW) * D) + lane;
#pragma unroll
                for (int j = 0; j < 4; ++j) { v[u][j] = xr[64 * j]; s[u] += dot4(v[u][j]); } }
#pragma unroll
            for (int o = 1; o < 64; o <<= 1) {
#pragma unroll
                for (int u = 0; u < 4; ++u) s[u] += __shfl_xor(s[u], o); }
#pragma unroll
            for (int u = 0; u < 4; ++u) { f32x4* xr = (f32x4*)((args.dry ? (float*)(args.ws + WS_QA) : OUT_P) + (size_t)(m0 + u * NGW) * D) + lane; const float rstd = 1.f / sqrtf(s[u] * (1.f / 1024.f) + EPS);
#pragma unroll
                for (int j = 0; j < 4; ++j) xr[64 * j] = v[u][j] * rstd * wr[64 * j]; }
        }
    }
#undef IN
#undef SEAM
}

extern "C" void kernel_launch(void* const* d_in, const int* in_sizes, int n_in, void* d_out, int out_size, void* d_ws, size_t ws_size, hipStream_t stream) {
    static int grid = 0;
    if (grid == 0) {
        int dev = 0, cus = 0, per_cu = 0;
        hipGetDevice(&dev);
        hipDeviceGetAttribute(&cus, hipDeviceAttributeMultiprocessorCount, dev);
        if (hipFuncSetAttribute((const void*)mk_fwd, hipFuncAttributeMaxDynamicSharedMemorySize, LDS_BYTES) != hipSuccess) { fprintf(stderr, "kernel_launch: hipFuncSetAttribute failed\n"); }
        if (hipOccupancyMaxActiveBlocksPerMultiprocessor(&per_cu, (const void*)mk_fwd, 512, LDS_BYTES) != hipSuccess || per_cu < 1) { fprintf(stderr, "kernel_launch: occupancy query gave %d\n", per_cu); per_cu = 1; }
        (void)hipGetLastError();
        if (per_cu > 1) per_cu = 1;
        grid = cus * per_cu;
        if (n_in != 22 || ws_size < 256 * MiB) fprintf(stderr, "kernel_launch: unexpected n_in %d / ws %zu\n", n_in, ws_size);
    }
    Args a{};
    for (int i = 0; i < 22; ++i) a.in[i] = (const float*)d_in[i];
    a.out = (float*)d_out; a.ws = (unsigned char*)d_ws;
#if MK_N_LAUNCHES == 1
    a.ph_lo = 0; a.ph_hi = NPH;
    void* kargs[] = {&a};
    hipError_t e = hipLaunchCooperativeKernel((const void*)mk_fwd, dim3(grid), dim3(512), kargs, LDS_BYTES, stream);
    if (e != hipSuccess) fprintf(stderr, "cooperative launch failed: %s (grid %d)\n", hipGetErrorString(e), grid);
#else
    for (int li = 0; li < NPH; ++li) { a.ph_lo = li; a.ph_hi = li + 1; hipLaunchKernelGGL(mk_fwd, dim3(grid), dim3(512), LDS_BYTES, stream, a);
#ifdef DUPLAUNCH
        if (li == DUPLAUNCH) { a.dry = 1; hipLaunchKernelGGL(mk_fwd, dim3(grid), dim3(512), LDS_BYTES, stream, a); a.dry = 0; }
#endif
    }
#endif
}
```

```cpp
#define MK_N_LAUNCHES 1
#include <hip/hip_runtime.h>
#include <hip/hip_cooperative_groups.h>
#include <cstdio>
#include <cstdint>
#include <cstddef>
namespace cg = cooperative_groups;
namespace pg8 {
#define PG8_LAS __attribute__((address_space(3)))
typedef unsigned short bf16_t;
typedef short bf16x8 __attribute__((ext_vector_type(8)));
typedef float f32x4 __attribute__((ext_vector_type(4)));
typedef unsigned u32x4 __attribute__((ext_vector_type(4)));
constexpr int BM = 256, BK = 64, HALF = 128, HTB = HALF * BK * 2  , STAGE_BYTES = 8 * HTB, NXCD = 8, WGM = 4;

__host__ __device__ __forceinline__ int lds_byte(int r, int c) { const int st = (r >> 4) * 2 + (c >> 5), rr = r & 15, cc = c & 31, ob = rr * 64 + cc * 2; return st * 1024 + (ob ^ (((ob >> 9) & 1) << 5)); }
__host__ __device__ __forceinline__ void stage_rc(int b, int& R, int& C) { const int st = b / 1024, sb = b % 1024, swz = sb ^ (((sb >> 9) & 1) << 5); R = (st >> 1) * 16 + swz / 64; C = (st & 1) * 32 + (swz % 64) / 2; }
__host__ __device__ __forceinline__ int perm32(int rho) { const int n = rho >> 4, i = rho & 15; return 8 * (i >> 2) + 4 * n + (i & 3); }

struct Unit { int pm, pn; };
struct Gemm { const bf16_t* A; const bf16_t* Bt; int M, N, K; };

struct StaticOrder {
    int nM, nN, nwg, G, c;
    __host__ __device__ void init(int M, int N, int G_, int c_) { nM = M / BM; nN = N / BM; nwg = nM * nN; G = G_; c = c_; }
    __host__ __device__ bool next(int i, Unit& u) const {
        const long L = (long)i * G + c; if (L >= nwg) return false;
        int wgid = (int)L; { const int q = nwg / NXCD, r = nwg % NXCD, xcd = wgid % NXCD, off = wgid / NXCD; wgid = (xcd < r ? xcd * (q + 1) : r * (q + 1) + (xcd - r) * q) + off; }
        const int nig = WGM * nN, gid = wgid / nig, fm = gid * WGM, gsz = (nM - fm) < WGM ? (nM - fm) : WGM;
        u.pm = fm + ((wgid % nig) % gsz); u.pn = (wgid % nig) / gsz; return true;
    }
    __device__ __forceinline__ void a_ready(const Unit&) const {}
    __device__ __forceinline__ void done(const Unit&) const {}
};

__device__ __forceinline__ unsigned cvt_pk_bf16(float lo, float hi) { unsigned r; asm volatile("v_cvt_pk_bf16_f32 %0, %1, %2" : "=v"(r) : "v"(lo), "v"(hi)); return r; }
typedef float f32x2 __attribute__((ext_vector_type(2)));
struct OneUnit {
    int pm, pn;
    __host__ __device__ bool next(int i, Unit& u) const { if (i != 0) return false; u.pm = pm; u.pn = pn; return true; }
    __device__ __forceinline__ void a_ready(const Unit&) const {}
    __device__ __forceinline__ void done(const Unit&) const {}
};
struct StrideOrder {
    int first, stride, n;
    __host__ __device__ bool next(int i, Unit& u) const { const int L = first + i * stride; if (L >= n) return false; u.pm = L >> 2; u.pn = L & 3; return true; }
    __device__ __forceinline__ void a_ready(const Unit&) const {}
    __device__ __forceinline__ void done(const Unit&) const {}
};
typedef float f32x2_t __attribute__((ext_vector_type(2))); typedef __bf16 bf16x2_t __attribute__((ext_vector_type(2)));
__device__ __forceinline__ unsigned cvtpk(float lo, float hi) { f32x2_t v = {lo, hi}; bf16x2_t b = __builtin_convertvector(v, bf16x2_t); return __builtin_bit_cast(unsigned, b); }
__device__ __forceinline__ void st8(bf16_t* p, f32x4 v0, f32x4 v1) { u32x4 w; w.x = cvtpk(v0[0], v0[1]); w.y = cvtpk(v0[2], v0[3]); w.z = cvtpk(v1[0], v1[1]); w.w = cvtpk(v1[2], v1[3]); *(u32x4*)p = w; }
__device__ __forceinline__ void ld8(const bf16_t* p, f32x4& v0, f32x4& v1) { const u32x4 w = *(const u32x4*)p;
    v0[0] = __uint_as_float(w.x << 16); v0[1] = __uint_as_float(w.x & 0xffff0000u); v0[2] = __uint_as_float(w.y << 16); v0[3] = __uint_as_float(w.y & 0xffff0000u);
    v1[0] = __uint_as_float(w.z << 16); v1[1] = __uint_as_float(w.z & 0xffff0000u); v1[2] = __uint_as_float(w.w << 16); v1[3] = __uint_as_float(w.w & 0xffff0000u); }
__device__ __forceinline__ float sigm(float v) { return __builtin_amdgcn_rcpf(1.f + __expf(-v)); }
__device__ __forceinline__ f32x4 sigm4(f32x4 v) { return (f32x4){sigm(v[0]), sigm(v[1]), sigm(v[2]), sigm(v[3])}; }
__device__ __forceinline__ float dot4(f32x4 a) { return (a[0] * a[0] + a[1] * a[1]) + (a[2] * a[2] + a[3] * a[3]); }

struct EpiProj {
    static constexpr bool PERM = true, AFTER_DRAIN = false;
    bf16_t *QA, *KA, *VTa, *QG, *KG, *VTg, *GG, *GT; const float* bgate;
    __device__ __forceinline__ void operator()(const f32x4 (&acc)[2][2][4][2], const Unit& u, int wr, int wc, int fr, int fq) const {
        const int row0 = u.pm * BM + wr * 64 + fr;
#pragma unroll
        for (int bj = 0; bj < 2; ++bj) {
            const int hb = 2 * u.pn + bj;
            int mode = 0, ld, c0; bf16_t* dst;
            if (hb < 8) { dst = QA; ld = 1024; c0 = 128 * hb; }
            else if (hb == 8) { dst = KA; ld = 128; c0 = 0; }
            else if (hb == 9) { mode = 1; dst = VTa; ld = 128; c0 = 0; }
            else if (hb < 14) { dst = QG; ld = 512; c0 = 128 * (hb - 10); }
            else if (hb < 18) { dst = KG; ld = 512; c0 = 128 * (hb - 14); }
            else if (hb < 26) { mode = 1; dst = VTg; ld = 1024; c0 = 128 * (hb - 18); }
            else if (hb < 34) { mode = 2; dst = GG; ld = 1024; c0 = 128 * (hb - 26); }
            else { mode = 3; dst = GT; ld = 2048; c0 = 128 * (hb - 34); }
            const int cl = c0 + wc * 32 + 8 * fq;
            if (mode == 1) {
                const int b = (u.pm * BM) >> 13, t0 = (row0 & 8191);
                unsigned short* pb = (unsigned short*)dst + ((size_t)(b * ld + cl)) * 8192 + t0;
#pragma unroll
                for (int ai = 0; ai < 2; ++ai)
#pragma unroll
                    for (int m = 0; m < 4; ++m) {
                        unsigned short* p = pb + ai * HALF + m * 16;
#pragma unroll
                        for (int n = 0; n < 2; ++n) { const f32x4 v = acc[ai][bj][m][n]; const unsigned w0 = cvtpk(v[0], v[1]), w1 = cvtpk(v[2], v[3]);
                            p[(size_t)(4 * n + 0) * 8192] = (unsigned short)(w0 & 0xffffu); p[(size_t)(4 * n + 1) * 8192] = (unsigned short)(w0 >> 16);
                            p[(size_t)(4 * n + 2) * 8192] = (unsigned short)(w1 & 0xffffu); p[(size_t)(4 * n + 3) * 8192] = (unsigned short)(w1 >> 16); }
                    }
            } else {
                f32x4 b0 = {0.f, 0.f, 0.f, 0.f}, b1 = {0.f, 0.f, 0.f, 0.f};
                if (mode == 3) { b0 = *(const f32x4*)(bgate + cl); b1 = *(const f32x4*)(bgate + cl + 4); }
#pragma unroll
                for (int ai = 0; ai < 2; ++ai)
#pragma unroll
                    for (int m = 0; m < 4; ++m) {
                        f32x4 v0 = acc[ai][bj][m][0], v1 = acc[ai][bj][m][1];
                        if (mode == 3) { v0 = v0 + b0; v1 = v1 + b1; }
                        st8(dst + (size_t)(row0 + ai * HALF + m * 16) * ld + cl, v0, v1);
                    }
            }
        }
    }
};
struct EpiMemKV {
    static constexpr bool PERM = true, AFTER_DRAIN = false;
    bf16_t *KM, *VmT;
    __device__ __forceinline__ void operator()(const f32x4 (&acc)[2][2][4][2], const Unit& u, int wr, int wc, int fr, int fq) const {
        const int rl = wr * 64 + fr;
#pragma unroll
        for (int bj = 0; bj < 2; ++bj) {
            const int cl = bj * HALF + wc * 32 + 8 * fq;
#pragma unroll
            for (int ai = 0; ai < 2; ++ai)
#pragma unroll
                for (int m = 0; m < 4; ++m) {
                    const int r = rl + ai * HALF + m * 16;
                    if (u.pn == 0) st8(KM + (size_t)(u.pm * BM + r) * 256 + cl, acc[ai][bj][m][0], acc[ai][bj][m][1]);
                    else { unsigned short* p = (unsigned short*)VmT + ((size_t)(u.pm * 256 + cl)) * 256 + r;
#pragma unroll
                        for (int n = 0; n < 2; ++n) { const f32x4 v = acc[ai][bj][m][n]; const unsigned w0 = cvtpk(v[0], v[1]), w1 = cvtpk(v[2], v[3]);
                            p[(4 * n + 0) * 256] = (unsigned short)(w0 & 0xffffu); p[(4 * n + 1) * 256] = (unsigned short)(w0 >> 16);
                            p[(4 * n + 2) * 256] = (unsigned short)(w1 & 0xffffu); p[(4 * n + 3) * 256] = (unsigned short)(w1 >> 16); } }
                }
        }
    }
};
struct EpiGate {
    static constexpr bool PERM = true, AFTER_DRAIN = false;
    const bf16_t* GT; bf16_t* TMP; bf16_t* OUT; int second;
    __device__ __forceinline__ void operator()(const f32x4 (&acc)[2][2][4][2], const Unit& u, int wr, int wc, int fr, int fq) const {
        const int row0 = u.pm * BM + wr * 64 + fr, c0 = u.pn * BM + wc * 32 + 8 * fq;
#pragma unroll
        for (int ai = 0; ai < 2; ++ai) {
            u32x4 gv[4][2], tv[4][2];
#pragma unroll
            for (int m = 0; m < 4; ++m)
#pragma unroll
                for (int bj = 0; bj < 2; ++bj) { const size_t row = (size_t)(row0 + ai * HALF + m * 16); const int c = c0 + bj * HALF;
                    gv[m][bj] = *(const u32x4*)(GT + row * 2048 + (second ? 1024 : 0) + c);
                    if (second) tv[m][bj] = *(const u32x4*)(TMP + row * 1024 + c); }
#pragma unroll
            for (int m = 0; m < 4; ++m)
#pragma unroll
                for (int bj = 0; bj < 2; ++bj) { const size_t row = (size_t)(row0 + ai * HALF + m * 16); const int c = c0 + bj * HALF;
                    const u32x4 w = gv[m][bj];
                    const f32x4 g0 = {__uint_as_float(w.x << 16), __uint_as_float(w.x & 0xffff0000u), __uint_as_float(w.y << 16), __uint_as_float(w.y & 0xffff0000u)};
                    const f32x4 g1 = {__uint_as_float(w.z << 16), __uint_as_float(w.z & 0xffff0000u), __uint_as_float(w.w << 16), __uint_as_float(w.w & 0xffff0000u)};
                    f32x4 v0 = acc[ai][bj][m][0] * sigm4(g0), v1 = acc[ai][bj][m][1] * sigm4(g1);
                    if (second) { const u32x4 t = tv[m][bj];
                        v0 += (f32x4){__uint_as_float(t.x << 16), __uint_as_float(t.x & 0xffff0000u), __uint_as_float(t.y << 16), __uint_as_float(t.y & 0xffff0000u)};
                        v1 += (f32x4){__uint_as_float(t.z << 16), __uint_as_float(t.z & 0xffff0000u), __uint_as_float(t.w << 16), __uint_as_float(t.w & 0xffff0000u)};
                        st8(OUT + row * 1024 + c, v0, v1); }
                    else st8(TMP + row * 1024 + c, v0, v1); }
        }
    }
};
struct EpiResid {
    static constexpr bool PERM = true, AFTER_DRAIN = false;
    const float* basef; const bf16_t* baseb; float* out; bf16_t* xb; float* ssq;
    __device__ __forceinline__ void operator()(const f32x4 (&acc)[2][2][4][2], const Unit& u, int wr, int wc, int fr, int fq) const {
        const int row0 = u.pm * BM + wr * 64 + fr, c0 = u.pn * BM + wc * 32 + 8 * fq;
#pragma unroll
        for (int ai = 0; ai < 2; ++ai) {
            f32x4 bs[4][2][2];
#pragma unroll
            for (int m = 0; m < 4; ++m)
#pragma unroll
                for (int bj = 0; bj < 2; ++bj) { const size_t off = (size_t)(row0 + ai * HALF + m * 16) * 1024 + c0 + bj * HALF;
                    if (basef) { bs[m][bj][0] = *(const f32x4*)(basef + off); bs[m][bj][1] = *(const f32x4*)(basef + off + 4); } else ld8(baseb + off, bs[m][bj][0], bs[m][bj][1]); }
#pragma unroll
            for (int m = 0; m < 4; ++m) {
                const size_t row = (size_t)(row0 + ai * HALF + m * 16); float s = 0.f;
#pragma unroll
                for (int bj = 0; bj < 2; ++bj) {
                    const int c = c0 + bj * HALF;
                    const f32x4 x0 = bs[m][bj][0] + acc[ai][bj][m][0], x1 = bs[m][bj][1] + acc[ai][bj][m][1];
                    if (out) { *(f32x4*)(out + row * 1024 + c) = x0; *(f32x4*)(out + row * 1024 + c + 4) = x1; }
                    if (xb) st8(xb + row * 1024 + c, x0, x1);
                    s += dot4(x0) + dot4(x1);
                }
                if (ssq) { s += __shfl_xor(s, 16); s += __shfl_xor(s, 32); if (fq == 0) atomicAdd(ssq + row, s); }
            }
        }
    }
};
struct EpiFinal {
    static constexpr bool PERM = true, AFTER_DRAIN = true;
    const bf16_t* base; float* out; const float* wf; float* xslots; unsigned* cnt;
    __device__ __forceinline__ void fused(f32x4 (&acc)[2][2][4][2], const Unit& u, int wr, int wc, int fr, int fq, PG8_LAS unsigned char* lds, int wid, int lane) const {
        PG8_LAS float* P = (PG8_LAS float*)lds;
        PG8_LAS float* R = (PG8_LAS float*)(lds + 4096);
        const int row0 = u.pm * BM + wr * 64 + fr, c0 = u.pn * BM + wc * 32 + 8 * fq;
#pragma unroll
        for (int ai = 0; ai < 2; ++ai) {
            f32x4 bs[4][2][2];
#pragma unroll
            for (int m = 0; m < 4; ++m)
#pragma unroll
                for (int bj = 0; bj < 2; ++bj) ld8(base + (size_t)(row0 + ai * HALF + m * 16) * 1024 + c0 + bj * HALF, bs[m][bj][0], bs[m][bj][1]);
#pragma unroll
            for (int m = 0; m < 4; ++m) {
                float s = 0.f;
#pragma unroll
                for (int bj = 0; bj < 2; ++bj) { acc[ai][bj][m][0] += bs[m][bj][0]; acc[ai][bj][m][1] += bs[m][bj][1]; s += dot4(acc[ai][bj][m][0]) + dot4(acc[ai][bj][m][1]); }
                s += __shfl_xor(s, 16); s += __shfl_xor(s, 32);
                if (fq == 0) P[(ai * HALF + wr * 64 + m * 16 + fr) * 4 + wc] = s;
            }
        }
        asm volatile("s_waitcnt lgkmcnt(0)" ::: "memory"); __builtin_amdgcn_s_barrier(); asm volatile("" ::: "memory");
        const int tid = wid * 64 + lane;
        if (tid < 256) {
            const float s = (P[tid * 4] + P[tid * 4 + 1]) + (P[tid * 4 + 2] + P[tid * 4 + 3]);
            __hip_atomic_store(xslots + (size_t)(u.pm * BM + tid) * 4 + u.pn, s, __ATOMIC_RELAXED, __HIP_MEMORY_SCOPE_AGENT);
            asm volatile("s_waitcnt vmcnt(0)" ::: "memory");
            if (lane == 0) __hip_atomic_fetch_add(cnt + 64 * u.pm, 1u, __ATOMIC_RELAXED, __HIP_MEMORY_SCOPE_AGENT);
        }
        if (wid == 0) {
            unsigned sp = 0;
            while ((unsigned)__builtin_amdgcn_readfirstlane(__hip_atomic_load(cnt + 64 * u.pm, __ATOMIC_RELAXED, __HIP_MEMORY_SCOPE_AGENT)) < 16u) { __builtin_amdgcn_s_sleep(2); if (++sp > (1u << 24)) break; }
            __builtin_amdgcn_fence(__ATOMIC_ACQUIRE, "agent");
        }
        asm volatile("s_waitcnt vmcnt(0) lgkmcnt(0)" ::: "memory"); __builtin_amdgcn_s_barrier(); asm volatile("" ::: "memory");
        if (tid < 256) {
            const float* sl = xslots + (size_t)(u.pm * BM + tid) * 4;
            const float s = (__hip_atomic_load(sl, __ATOMIC_RELAXED, __HIP_MEMORY_SCOPE_AGENT) + __hip_atomic_load(sl + 1, __ATOMIC_RELAXED, __HIP_MEMORY_SCOPE_AGENT))
                          + (__hip_atomic_load(sl + 2, __ATOMIC_RELAXED, __HIP_MEMORY_SCOPE_AGENT) + __hip_atomic_load(sl + 3, __ATOMIC_RELAXED, __HIP_MEMORY_SCOPE_AGENT));
            R[tid] = 1.0f / sqrtf(s * (1.f / 1024.f) + 1e-6f);
        }
        asm volatile("s_waitcnt vmcnt(0) lgkmcnt(0)" ::: "memory"); __builtin_amdgcn_s_barrier(); asm volatile("" ::: "memory");
        f32x4 w4[2][2];
#pragma unroll
        for (int bj = 0; bj < 2; ++bj) { w4[bj][0] = *(const f32x4*)(wf + c0 + bj * HALF); w4[bj][1] = *(const f32x4*)(wf + c0 + bj * HALF + 4); }
#pragma unroll
        for (int ai = 0; ai < 2; ++ai)
#pragma unroll
            for (int m = 0; m < 4; ++m) {
                const int rl = ai * HALF + wr * 64 + m * 16 + fr; const float r = R[rl]; float* op = out + (size_t)(u.pm * BM + rl) * 1024 + c0;
#pragma unroll
                for (int bj = 0; bj < 2; ++bj) { *(f32x4*)(op + bj * HALF) = acc[ai][bj][m][0] * r * w4[bj][0]; *(f32x4*)(op + bj * HALF + 4) = acc[ai][bj][m][1] * r * w4[bj][1]; }
            }
    }
};
struct EpiScaleQ {
    static constexpr bool PERM = true, AFTER_DRAIN = false;
    bf16_t* QM; const float* ssq;
    __device__ __forceinline__ void operator()(const f32x4 (&acc)[2][2][4][2], const Unit& u, int wr, int wc, int fr, int fq) const {
        const int row0 = u.pm * BM + wr * 64 + fr;
        float sq[2][4];
#pragma unroll
        for (int ai = 0; ai < 2; ++ai)
#pragma unroll
            for (int m = 0; m < 4; ++m) sq[ai][m] = ssq[row0 + ai * HALF + m * 16];
#pragma unroll
        for (int ai = 0; ai < 2; ++ai)
#pragma unroll
            for (int m = 0; m < 4; ++m) {
                const size_t row = (size_t)(row0 + ai * HALF + m * 16);
                const float r = 0.125f * __builtin_amdgcn_rsqf(sq[ai][m] * (1.f / 1024.f) + 1e-6f);
#pragma unroll
                for (int bj = 0; bj < 2; ++bj) st8(QM + row * 256 + bj * HALF + wc * 32 + 8 * fq, acc[ai][bj][m][0] * r, acc[ai][bj][m][1] * r);
            }
    }
};
struct EpiSwiglu {
    static constexpr bool PERM = true, AFTER_DRAIN = false;
    bf16_t* ACT; const float* ssq;
    __device__ __forceinline__ void operator()(const f32x4 (&acc)[2][2][4][2], const Unit& u, int wr, int wc, int fr, int fq) const {
        const int row0 = u.pm * BM + wr * 64 + fr;
        float sq[2][4];
#pragma unroll
        for (int ai = 0; ai < 2; ++ai)
#pragma unroll
            for (int m = 0; m < 4; ++m) sq[ai][m] = ssq[row0 + ai * HALF + m * 16];
#pragma unroll
        for (int ai = 0; ai < 2; ++ai)
#pragma unroll
            for (int m = 0; m < 4; ++m) {
                const size_t row = (size_t)(row0 + ai * HALF + m * 16);
                const float r = __builtin_amdgcn_rsqf(sq[ai][m] * (1.f / 1024.f) + 1e-6f);
                const f32x4 g0 = acc[ai][0][m][0] * r, g1 = acc[ai][0][m][1] * r, u0 = acc[ai][1][m][0] * r, u1 = acc[ai][1][m][1] * r;
                st8(ACT + row * 2816 + u.pn * HALF + wc * 32 + 8 * fq, g0 * sigm4(g0) * u0, g1 * sigm4(g1) * u1);
            }
    }
};
template <class Epi, class Sched, bool ALIGN_EPI = false, bool SP2 = false>
__device__ __forceinline__ void gemm_phase(PG8_LAS unsigned char* lds, const Gemm g, const Sched& S, const Epi& E) {
    const int tid = threadIdx.x, wid = __builtin_amdgcn_readfirstlane(tid >> 6), lane = tid & 63, wr = wid >> 2, wc = wid & 3, fr = lane & 15, fq = lane >> 4;
    const int K = g.K, nt = K / BK;
    unsigned voffA[2], voffB[2];
#pragma unroll
    for (int i = 0; i < 2; ++i) { int R, C; stage_rc(tid * 16 + i * 8192, R, C); const int Rb = Epi::PERM ? ((R & ~31) + perm32(R & 31)) : R;
        voffA[i] = (unsigned)(R * K + C) * 2u; voffB[i] = (unsigned)(Rb * K + C) * 2u; }
    const size_t kstep = (size_t)(BK * 2);
    const size_t hstep = (size_t)HALF * K * 2;
    const size_t tstep = 2 * hstep;
    const unsigned ldsw = (unsigned)wid * 1024u;
    const int aoff = lds_byte(wr * 64 + fr, fq * 8), boff = lds_byte(wc * 32 + fr, fq * 8);
#define PG8_SA(b, h) (((b) * 2 + (h)) * HTB)
#define PG8_SB(b, h) ((4 + (b) * 2 + (h)) * HTB)
#define PG8_STAGE(bufoff, gbase, voff) do { _Pragma("unroll") for (int _i = 0; _i < 2; ++_i) \
        __builtin_amdgcn_global_load_lds((const unsigned*)((const char*)(gbase) + (voff)[_i]), (PG8_LAS unsigned*)(lds + (bufoff) + ldsw + _i * 8192), 16, 0, 0); } while (0)
#define PG8_LDA(dst, b, h) do { _Pragma("unroll") for (int m = 0; m < 4; ++m) _Pragma("unroll") for (int k = 0; k < 2; ++k) dst[m][k] = *(const PG8_LAS bf16x8*)(lds + PG8_SA(b, h) + aoff + m * 2048 + k * 1024); } while (0)
#define PG8_LDB(dst, b, h) do { _Pragma("unroll") for (int n = 0; n < 2; ++n) _Pragma("unroll") for (int k = 0; k < 2; ++k) dst[n][k] = *(const PG8_LAS bf16x8*)(lds + PG8_SB(b, h) + boff + n * 2048 + k * 1024); } while (0)
#define PG8_MMA(ai, bj, At, Bt) do { __builtin_amdgcn_s_setprio(1); _Pragma("unroll") for (int m = 0; m < 4; ++m) _Pragma("unroll") for (int n = 0; n < 2; ++n) _Pragma("unroll") for (int k = 0; k < 2; ++k) \
        acc[ai][bj][m][n] = __builtin_amdgcn_mfma_f32_16x16x32_bf16(Bt[n][k], At[m][k], acc[ai][bj][m][n], 0, 0, 0); __builtin_amdgcn_s_setprio(0); } while (0)
#define PG8_WAIT_V(n) asm volatile("s_waitcnt vmcnt(" #n ")" ::: "memory")
#define PG8_WAIT_L(n) asm volatile("s_waitcnt lgkmcnt(" #n ")" ::: "memory")
#define PG8_BAR __builtin_amdgcn_s_barrier()
#define PG8_SCHED __builtin_amdgcn_sched_barrier(0)
    Unit cur, nxt; int ui = 0;
    if (!S.next(0, cur)) return;
    f32x4 acc[2][2][4][2];
#pragma unroll
    for (int a = 0; a < 2; ++a)
#pragma unroll
        for (int b = 0; b < 2; ++b)
#pragma unroll
            for (int m = 0; m < 4; ++m)
#pragma unroll
                for (int n = 0; n < 2; ++n) acc[a][b][m][n] = (f32x4){0.f, 0.f, 0.f, 0.f};
    bf16x8 At[4][2], B0[2][2], B1[2][2];
    const char* cA = (const char*)g.A + (size_t)cur.pm * tstep; const char* cB = (const char*)g.Bt + (size_t)cur.pn * tstep;
    S.a_ready(cur);
    if constexpr (SP2) {
        PG8_STAGE(PG8_SB(0, 0), cB, voffB); PG8_STAGE(PG8_SB(0, 1), cB + hstep, voffB); PG8_STAGE(PG8_SA(0, 0), cA, voffA); PG8_STAGE(PG8_SA(0, 1), cA + hstep, voffA);
        if (wr == 1) PG8_BAR;
        PG8_WAIT_V(2); PG8_BAR;
        PG8_STAGE(PG8_SB(1, 0), cB + kstep, voffB); PG8_STAGE(PG8_SA(1, 0), cA + kstep, voffA); PG8_STAGE(PG8_SB(1, 1), cB + hstep + kstep, voffB);
        PG8_WAIT_V(6); PG8_BAR;
    } else {
        PG8_STAGE(PG8_SB(0, 0), cB, voffB); PG8_STAGE(PG8_SA(0, 0), cA, voffA); PG8_STAGE(PG8_SB(0, 1), cB + hstep, voffB); PG8_STAGE(PG8_SA(0, 1), cA + hstep, voffA);
        if (wr == 1) PG8_BAR;
        PG8_WAIT_V(4); PG8_BAR;
        PG8_STAGE(PG8_SB(1, 0), cB + kstep, voffB); PG8_STAGE(PG8_SA(1, 0), cA + kstep, voffA); PG8_STAGE(PG8_SB(1, 1), cB + hstep + kstep, voffB);
        PG8_WAIT_V(6); PG8_BAR;
    }
    for (;;) {
        const bool has_next = S.next(ui + 1, nxt);
        const char* nA = has_next ? (const char*)g.A + (size_t)nxt.pm * tstep : cA; const char* nB = has_next ? (const char*)g.Bt + (size_t)nxt.pn * tstep : cB;
        for (int t = 0; t < nt; t += 2) {
            const bool last = (t == nt - 2);
            const char* a1 = cA + (size_t)(t + 1) * kstep;
            const char* a2 = last ? nA : cA + (size_t)(t + 2) * kstep; const char* b2 = last ? nB : cB + (size_t)(t + 2) * kstep;
            const char* a3 = a2 + kstep; const char* b3 = b2 + kstep;
            if (last && has_next) S.a_ready(nxt);
            if constexpr (SP2) {
            PG8_LDB(B0, 0, 0); PG8_LDB(B1, 0, 1); PG8_SCHED; PG8_LDA(At, 0, 0); PG8_STAGE(PG8_SA(1, 1), a1 + hstep, voffA);
            PG8_WAIT_V(8); PG8_WAIT_L(0); PG8_BAR; PG8_MMA(0, 0, At, B0); PG8_MMA(0, 1, At, B1); PG8_BAR; PG8_SCHED;
            PG8_LDA(At, 0, 1); PG8_STAGE(PG8_SB(0, 0), b2, voffB); PG8_STAGE(PG8_SB(0, 1), b2 + hstep, voffB); PG8_STAGE(PG8_SA(0, 0), a2, voffA);
            PG8_WAIT_V(8); PG8_WAIT_L(0); PG8_BAR; PG8_MMA(1, 0, At, B0); PG8_MMA(1, 1, At, B1); PG8_BAR; PG8_SCHED;
            PG8_LDB(B0, 1, 0); PG8_LDB(B1, 1, 1); PG8_SCHED; PG8_LDA(At, 1, 0); PG8_STAGE(PG8_SA(0, 1), a2 + hstep, voffA);
            PG8_WAIT_V(8); PG8_WAIT_L(0); PG8_BAR; PG8_MMA(0, 0, At, B0); PG8_MMA(0, 1, At, B1); PG8_BAR; PG8_SCHED;
            PG8_LDA(At, 1, 1); PG8_STAGE(PG8_SB(1, 0), b3, voffB); PG8_STAGE(PG8_SB(1, 1), b3 + hstep, voffB); PG8_STAGE(PG8_SA(1, 0), a3, voffA);
            PG8_WAIT_V(8); PG8_WAIT_L(0); PG8_BAR; PG8_MMA(1, 0, At, B0); PG8_MMA(1, 1, At, B1); PG8_BAR; PG8_SCHED;
            } else {
            PG8_LDB(B0, 0, 0); PG8_SCHED; PG8_LDA(At, 0, 0); PG8_STAGE(PG8_SA(1, 1), a1 + hstep, voffA);
            PG8_WAIT_L(8); PG8_BAR; PG8_WAIT_L(0); PG8_MMA(0, 0, At, B0); PG8_BAR; PG8_SCHED;
            PG8_LDB(B1, 0, 1); PG8_STAGE(PG8_SB(0, 0), b2, voffB);
            PG8_BAR; PG8_WAIT_L(0); PG8_MMA(0, 1, At, B1); PG8_BAR;
            PG8_LDA(At, 0, 1); PG8_STAGE(PG8_SA(0, 0), a2, voffA);
            PG8_BAR; PG8_WAIT_L(0); PG8_MMA(1, 0, At, B0); PG8_BAR; PG8_SCHED;
            PG8_STAGE(PG8_SB(0, 1), b2 + hstep, voffB);
            PG8_WAIT_V(6); PG8_BAR; PG8_MMA(1, 1, At, B1); PG8_BAR;
            PG8_LDB(B0, 1, 0); PG8_SCHED; PG8_LDA(At, 1, 0); PG8_STAGE(PG8_SA(0, 1), a2 + hstep, voffA);
            PG8_WAIT_L(8); PG8_BAR; PG8_WAIT_L(0); PG8_MMA(0, 0, At, B0); PG8_BAR; PG8_SCHED;
            PG8_LDB(B1, 1, 1); PG8_STAGE(PG8_SB(1, 0), b3, voffB);
            PG8_BAR; PG8_WAIT_L(0); PG8_MMA(0, 1, At, B1); PG8_BAR;
            PG8_LDA(At, 1, 1); PG8_STAGE(PG8_SA(1, 0), a3, voffA);
            PG8_BAR; PG8_WAIT_L(0); PG8_MMA(1, 0, At, B0); PG8_BAR; PG8_SCHED;
            PG8_STAGE(PG8_SB(1, 1), b3 + hstep, voffB);
            PG8_WAIT_V(6); PG8_BAR; PG8_MMA(1, 1, At, B1); PG8_BAR;
            }
        }
        if constexpr (ALIGN_EPI) { if (wr == 0) PG8_BAR; }
        if constexpr (!Epi::AFTER_DRAIN) { E(acc, cur, wr, wc, fr, fq); S.done(cur); }
        if (!has_next) break;
#pragma unroll
        for (int a = 0; a < 2; ++a)
#pragma unroll
            for (int b = 0; b < 2; ++b)
#pragma unroll
                for (int m = 0; m < 4; ++m)
#pragma unroll
                    for (int n = 0; n < 2; ++n) acc[a][b][m][n] = (f32x4){0.f, 0.f, 0.f, 0.f};
        cur = nxt; cA = nA; cB = nB; ++ui;
        if constexpr (ALIGN_EPI) { if (wr == 1) PG8_BAR; }
    }
    PG8_WAIT_V(0);
    if constexpr (!ALIGN_EPI) { if (wr == 0) PG8_BAR; }
    PG8_BAR;
    if constexpr (Epi::AFTER_DRAIN) { E.fused(acc, cur, wr, wc, fr, fq, lds, wid, lane); S.done(cur); }
#undef PG8_SA
#undef PG8_SB
#undef PG8_STAGE
#undef PG8_LDA
#undef PG8_LDB
#undef PG8_MMA
#undef PG8_WAIT_V
#undef PG8_WAIT_L
#undef PG8_BAR
#undef PG8_SCHED
}
}
#define GAS __attribute__((address_space(1)))
#define LAS __attribute__((address_space(3)))
typedef unsigned short bf16;
typedef unsigned v4u __attribute__((ext_vector_type(4)));
typedef unsigned v2u __attribute__((ext_vector_type(2)));
typedef float f32x4 __attribute__((ext_vector_type(4)));
typedef float f32x16 __attribute__((ext_vector_type(16)));
typedef short bf16x8 __attribute__((ext_vector_type(8)));
typedef short s16x4 __attribute__((ext_vector_type(4)));
using pg8::cvtpk;
#define MFMA16(a, b, c) __builtin_amdgcn_mfma_f32_16x16x32_bf16((a), (b), (c), 0, 0, 0)
#define MFMA32(a, b, c) __builtin_amdgcn_mfma_f32_32x32x16_bf16((a), (b), (c), 0, 0, 0)
#define LDS_WAIT() asm volatile("s_waitcnt lgkmcnt(0)" ::: "memory")

#define XB_TMO      128
#define XB_XCNT(j)  (256  + 64 * (j))
#define XB_XSUB(j)  (1280 + 64 * (j))
#define XB_XGEN(j)  (2304 + 64 * (j))
#define XB_TOP      3328
#define XB_TOPGEN   3392
#define XCD_BAR_WORDS 3456
#define XB_SPIN_CAP (1u << 18)

__device__ __forceinline__ unsigned xb_ld(unsigned* p)              { return __hip_atomic_load(p, __ATOMIC_RELAXED, __HIP_MEMORY_SCOPE_AGENT); }
__device__ __forceinline__ unsigned xb_add(unsigned* p, unsigned v) { return __hip_atomic_fetch_add(p, v, __ATOMIC_RELAXED, __HIP_MEMORY_SCOPE_AGENT); }
__device__ __forceinline__ unsigned xb_xcc_id() { return (unsigned)__builtin_amdgcn_s_getreg((3 << 11) | 20) & 0xFu; }
#define XB_SPIN(cond, bar) do { unsigned _sp = 0; while (cond) { __builtin_amdgcn_s_sleep(1); \
    if ((++_sp & 255u) == 0u) { if (xb_ld(&(bar)[XB_TMO])) break; if (_sp > XB_SPIN_CAP) { atomicAdd(&(bar)[XB_TMO], 1u); break; } } } } while (0)

struct XcdBarrier {
    unsigned* bar; unsigned x;
    volatile LAS unsigned* st;
};

__device__ __forceinline__ XcdBarrier xcd_barrier_post(unsigned* bar, volatile LAS unsigned* st) {
    XcdBarrier b; b.bar = bar; b.x = xb_xcc_id(); b.st = st;
    if (threadIdx.x == 0) (void)xb_add(&bar[XB_XCNT(b.x)], 1u);
    return b;
}
__device__ __forceinline__ void xcd_barrier_complete(unsigned* bar, unsigned x, unsigned& nloc, unsigned& nx) {
    const unsigned G = gridDim.x * gridDim.y * gridDim.z;
    unsigned sum, cnt, mine, sp = 0u;
    for (;;) {
        sum = 0u; cnt = 0u; mine = 0u;
#pragma unroll
        for (unsigned j = 0; j < 16; ++j) { const unsigned c = xb_ld(&bar[XB_XCNT(j)]); sum += c; cnt += (c > 0u) ? 1u : 0u; mine = (j == x) ? c : mine; }
        if (sum == G) break;
        __builtin_amdgcn_s_sleep(1);
        if ((++sp & 255u) == 0u) { if (xb_ld(&bar[XB_TMO])) break; if (sp > XB_SPIN_CAP) { atomicAdd(&bar[XB_TMO], 1u); break; } }
    }
    nloc = mine > 0u ? mine : 1u; nx = cnt > 0u ? cnt : 1u;
}

__device__ __forceinline__ void xcd_barrier(const XcdBarrier& b) {
    asm volatile("s_waitcnt vmcnt(0)" ::: "memory");
    __syncthreads();
    if (threadIdx.x == 0) {
        unsigned* bar = b.bar;
        __builtin_amdgcn_s_waitcnt(0);
        unsigned nloc = b.st[0], nx = b.st[1];
        if (nloc == 0u) { xcd_barrier_complete(bar, b.x, nloc, nx); b.st[0] = nloc; b.st[1] = nx; }
        const unsigned old = xb_add(&bar[XB_XSUB(b.x)], 1u);
        const unsigned gen = old / nloc;
        if (old + 1u == (gen + 1u) * nloc) {
            __builtin_amdgcn_fence(__ATOMIC_RELEASE, "agent");
            asm volatile("s_waitcnt vmcnt(0)" ::: "memory");
            const unsigned og = xb_add(&bar[XB_TOP], 1u);
            const unsigned tg = og / nx;
            if (og + 1u == (tg + 1u) * nx) xb_add(&bar[XB_TOPGEN], 1u);
            else XB_SPIN(xb_ld(&bar[XB_TOPGEN]) == tg, bar);
            __builtin_amdgcn_fence(__ATOMIC_ACQUIRE, "agent");
            xb_add(&bar[XB_XGEN(b.x)], 1u);
            asm volatile("s_waitcnt vmcnt(0)" ::: "memory");
        } else {
            XB_SPIN(xb_ld(&bar[XB_XGEN(b.x)]) == gen, bar);
            __builtin_amdgcn_fence(__ATOMIC_ACQUIRE, "agent");
            asm volatile("s_waitcnt vmcnt(0)" ::: "memory");
        }
    }
    __syncthreads();
}

constexpr int NB = 2, SEQ = 8192, D = 1024, T = NB * SEQ;
constexpr int INC = 6416, NPROJ = 6400, DFF = 2816;
constexpr float EPS = 1e-6f;
constexpr size_t MiB = 1u << 20;
constexpr size_t WS_SSQ = 0;
constexpr size_t WS_XSLOT = 256 * 1024;
constexpr size_t WS_BAR = 512 * 1024;
constexpr size_t WS_ADEC = 1 * MiB;
constexpr size_t WS_KM = 1 * MiB + 512 * 1024;
constexpr size_t WS_VMT = 1 * MiB + 768 * 1024;
constexpr size_t WS_MN = 2 * MiB;
constexpr size_t WS_WALR = 3 * MiB;
constexpr size_t WS_WIN = 4 * MiB;
constexpr size_t WS_WAO = 17 * MiB, WS_WGO = 19 * MiB, WS_WMIX = 21 * MiB, WS_WMKV = 23 * MiB;
constexpr size_t WS_H = 24 * MiB;
constexpr size_t WS_QA = 56 * MiB;
constexpr size_t WS_QM = 56 * MiB, WS_OM = 64 * MiB;
constexpr size_t WS_KA = 88 * MiB, WS_VTA = 92 * MiB, WS_QG = 96 * MiB, WS_KG = 112 * MiB;
constexpr size_t WS_OG = 88 * MiB;
constexpr size_t WS_MERGED = 56 * MiB;
constexpr size_t WS_VTG = 128 * MiB;
constexpr size_t WS_WGU = 128 * MiB, WS_WD = 139 * MiB;
constexpr size_t WS_WMQ = 16 * MiB + 512 * 1024, WS_WMO = 3 * MiB + 256 * 1024;
constexpr size_t WS_GG = 160 * MiB;
constexpr size_t WS_ACT = 160 * MiB;
constexpr size_t WS_GT = 192 * MiB;
constexpr int LDS_BYTES = 152576 + 64, MISC_OFF = 152576;
constexpr int NPH = 13;

__device__ __forceinline__ float wave_sum(float v) {
#pragma unroll
    for (int o = 1; o < 64; o <<= 1) v += __shfl_xor(v, o);
    return v;
}
__device__ __forceinline__ float dot4(f32x4 a) { return (a[0] * a[0] + a[1] * a[1]) + (a[2] * a[2] + a[3] * a[3]); }
__device__ __forceinline__ float bf2f(unsigned short u) { return __uint_as_float((unsigned)u << 16); }

__device__ __forceinline__ void transpose_item(const float* W, int ldw, int col0, int k0, bf16* WT, int K, int drow0, const float* ksc, LAS float* scr, int lane) {
    float tv[32];
#pragma unroll
    for (int i = 0; i < 32; ++i) { const int kk = 2 * i + (lane >> 5); tv[i] = W[(size_t)(k0 + kk) * ldw + col0 + (lane & 31)]; }
    if (ksc) {
#pragma unroll
        for (int i = 0; i < 32; ++i) tv[i] *= ksc[k0 + 2 * i + (lane >> 5)];
    }
#pragma unroll
    for (int i = 0; i < 32; ++i) { const int kk = 2 * i + (lane >> 5); scr[kk * 33 + (lane & 31)] = tv[i]; }
    LDS_WAIT(); asm volatile("" ::: "memory");
    const int c = lane & 7;
#pragma unroll
    for (int j = 0; j < 4; ++j) { const int n = (lane >> 3) + 8 * j; const LAS float* s = scr + (8 * c) * 33 + n;
        v4u o; o.x = cvtpk(s[0 * 33], s[1 * 33]); o.y = cvtpk(s[2 * 33], s[3 * 33]); o.z = cvtpk(s[4 * 33], s[5 * 33]); o.w = cvtpk(s[6 * 33], s[7 * 33]);
        *(v4u*)(WT + (size_t)(drow0 + n) * K + k0 + 8 * c) = o; }
    LDS_WAIT(); asm volatile("" ::: "memory");
}
__device__ __forceinline__ void rms_row_bf16(const float* xrow, const float* w, bf16* orow, int lane) {
    const f32x4* xr = (const f32x4*)xrow + lane; const f32x4* wr = (const f32x4*)w + lane;
    f32x4 v[4]; float s = 0.f;
#pragma unroll
    for (int j = 0; j < 4; ++j) { v[j] = xr[64 * j]; s += dot4(v[j]); }
    const float rstd = 1.f / sqrtf(wave_sum(s) * (1.f / 1024.f) + EPS);
    v2u* o8 = (v2u*)orow + lane;
#pragma unroll
    for (int j = 0; j < 4; ++j) { const f32x4 y = v[j] * rstd * wr[64 * j]; v2u o; o.x = cvtpk(y[0], y[1]); o.y = cvtpk(y[2], y[3]); o8[64 * j] = o; }
}

__device__ __forceinline__ void rms_row2_bf16(const float* x0, const float* x1, const float* w, bf16* o0, bf16* o1, int lane) {
    const f32x4* xa = (const f32x4*)x0 + lane; const f32x4* xb = (const f32x4*)x1 + lane; const f32x4* wr = (const f32x4*)w + lane;
    f32x4 a[4], b[4]; float sa = 0.f, sb = 0.f;
#pragma unroll
    for (int j = 0; j < 4; ++j) { a[j] = xa[64 * j]; b[j] = xb[64 * j]; }
#pragma unroll
    for (int j = 0; j < 4; ++j) { sa += dot4(a[j]); sb += dot4(b[j]); }
#pragma unroll
    for (int o = 1; o < 64; o <<= 1) { sa += __shfl_xor(sa, o); sb += __shfl_xor(sb, o); }
    const float ra = 1.f / sqrtf(sa * (1.f / 1024.f) + EPS), rb = 1.f / sqrtf(sb * (1.f / 1024.f) + EPS);
    v2u* pa = (v2u*)o0 + lane; v2u* pb = (v2u*)o1 + lane;
#pragma unroll
    for (int j = 0; j < 4; ++j) { const f32x4 ww = wr[64 * j]; const f32x4 ya = a[j] * ra * ww, yb = b[j] * rb * ww; v2u oa, ob; oa.x = cvtpk(ya[0], ya[1]); oa.y = cvtpk(ya[2], ya[3]); ob.x = cvtpk(yb[0], yb[1]); ob.y = cvtpk(yb[2], yb[3]); pa[64 * j] = oa; pb[64 * j] = ob; }
}

__device__ __forceinline__ void rms_row4_bf16(const float* x0, size_t rstride, const float* w, bf16* o0, int lane) {
    const f32x4* wr = (const f32x4*)w + lane;
    f32x4 a[4][4]; float sa[4] = {0.f, 0.f, 0.f, 0.f};
#pragma unroll
    for (int u = 0; u < 4; ++u) { const f32x4* xa = (const f32x4*)(x0 + u * rstride) + lane;
#pragma unroll
        for (int j = 0; j < 4; ++j) a[u][j] = xa[64 * j]; }
#pragma unroll
    for (int u = 0; u < 4; ++u)
#pragma unroll
        for (int j = 0; j < 4; ++j) sa[u] += dot4(a[u][j]);
#pragma unroll
    for (int o = 1; o < 64; o <<= 1) {
#pragma unroll
        for (int u = 0; u < 4; ++u) sa[u] += __shfl_xor(sa[u], o); }
#pragma unroll
    for (int u = 0; u < 4; ++u) { const float ra = 1.f / sqrtf(sa[u] * (1.f / 1024.f) + EPS); v2u* pa = (v2u*)(o0 + u * rstride) + lane;
#pragma unroll
        for (int j = 0; j < 4; ++j) { const f32x4 ya = a[u][j] * ra * wr[64 * j]; v2u oa; oa.x = cvtpk(ya[0], ya[1]); oa.y = cvtpk(ya[2], ya[3]); pa[64 * j] = oa; } }
}

__device__ __forceinline__ void gla_prep(int ch, const bf16* H, const bf16* WalrT, const float* W2, const float* B2, const bf16* KG, bf16* KD, float* Adec, LAS unsigned char* lds, int tid) {
    const int lane = tid & 63, w = tid >> 6, l16 = lane & 15, quad = lane >> 4;
    LAS float* red = (LAS float*)lds;
    LAS float* alr = (LAS float*)(lds + 32768);
    unsigned short kraw[64];
    { const bf16* kin0 = KG + (size_t)ch * 32768 + tid;
#pragma unroll
      for (int t = 0; t < 64; ++t) kraw[t] = kin0[t * 512]; }
    f32x4 acc[4];
#pragma unroll
    for (int mt = 0; mt < 4; ++mt) acc[mt] = (f32x4){0.f, 0.f, 0.f, 0.f};
#pragma unroll
    for (int ks = 0; ks < 4; ++ks) {
        const int k0 = 128 * w + 32 * ks + 8 * quad;
        const bf16x8 bfr = *(const bf16x8*)(WalrT + l16 * 1024 + k0);
#pragma unroll
        for (int mt = 0; mt < 4; ++mt) { const bf16x8 afr = *(const bf16x8*)(H + (size_t)(ch * 64 + 16 * mt + l16) * 1024 + k0); acc[mt] = MFMA16(afr, bfr, acc[mt]); }
    }
#pragma unroll
    for (int mt = 0; mt < 4; ++mt)
#pragma unroll
        for (int j = 0; j < 4; ++j) red[(w * 64 + 16 * mt + 4 * quad + j) * 16 + l16] = acc[mt][j];
    __syncthreads();
    for (int e = tid; e < 1024; e += 512) { float s = 0.f;
#pragma unroll
        for (int w2 = 0; w2 < 8; ++w2) s += red[w2 * 1024 + e];
        alr[e] = s; }
    __syncthreads();
    const int f = tid;
    float w2r[16];
#pragma unroll
    for (int r = 0; r < 16; ++r) w2r[r] = W2[r * 512 + f];
    const float bb = B2[f];
    float bc[64]; float run = 0.f;
#pragma unroll
    for (int t = 0; t < 64; ++t) {
        float z = bb;
#pragma unroll
        for (int r4 = 0; r4 < 4; ++r4) { const f32x4 a = *(const LAS f32x4*)(alr + t * 16 + 4 * r4); z += a[0] * w2r[4 * r4] + a[1] * w2r[4 * r4 + 1] + a[2] * w2r[4 * r4 + 2] + a[3] * w2r[4 * r4 + 3]; }
        const float ls = fminf(z, 0.f) - __logf(1.f + __expf(-fabsf(z)));
        run += ls * (1.f / 16.f); bc[t] = run;
    }
    const float bend = run;
    unsigned pk[32];
#pragma unroll
    for (int t2 = 0; t2 < 32; ++t2) { const float k0 = bf2f(kraw[2 * t2]), k1 = bf2f(kraw[2 * t2 + 1]);
        pk[t2] = cvtpk(k0 * __expf(bend - bc[2 * t2]), k1 * __expf(bend - bc[2 * t2 + 1])); }
    __syncthreads();
    v4u* dst = (v4u*)(KD + (size_t)ch * 32768 + f * 64);
#pragma unroll
    for (int i = 0; i < 8; ++i) dst[i] = (v4u){pk[4 * i], pk[4 * i + 1], pk[4 * i + 2], pk[4 * i + 3]};
    Adec[(size_t)ch * 512 + f] = __expf(bend);
    __syncthreads();
}

__device__ __forceinline__ bf16x8 pack8(const f32x16& x, const int s, const float sc) {
    v4u p; p.x = cvtpk(x[8 * s] * sc, x[8 * s + 1] * sc); p.y = cvtpk(x[8 * s + 2] * sc, x[8 * s + 3] * sc); p.z = cvtpk(x[8 * s + 4] * sc, x[8 * s + 5] * sc); p.w = cvtpk(x[8 * s + 6] * sc, x[8 * s + 7] * sc);
    return __builtin_bit_cast(bf16x8, p);
}
template <int NKT, bool SINK>
__device__ __forceinline__ void attend32(const bf16* qp, const bf16* kbase, ptrdiff_t koff, int kpitch, const bf16* vbase, ptrdiff_t voff, int vpitch, int nskip, float scale, float sink, bf16* op, int opitch, int lane) {
    asm volatile("" : "+v"(lane));
    const int r = lane & 31, hh = lane >> 5;
    bf16x8 qf[4];
#pragma unroll
    for (int s = 0; s < 4; ++s) qf[s] = *(const bf16x8*)(qp + 16 * s + 8 * hh);
    float m = -3.0e38f;
#pragma unroll
    for (int kt = 0; kt < NKT; ++kt) {
        const int kte = kt < nskip ? nskip : kt;
        const bf16* kr = kbase + (koff + (ptrdiff_t)(32 * kte + r) * kpitch + 8 * hh);
        f32x16 a;
#pragma unroll
        for (int i = 0; i < 16; ++i) a[i] = 0.f;
#pragma unroll
        for (int s = 0; s < 4; ++s) a = MFMA32(*(const bf16x8*)(kr + 16 * s), qf[s], a);
        float mt = a[0];
#pragma unroll
        for (int i = 1; i < 16; ++i) mt = fmaxf(mt, a[i]);
        m = fmaxf(m, (kt < nskip) ? -1e30f : mt * scale);
        asm volatile("" ::: "memory");
    }
    m = fmaxf(m, __shfl_xor(m, 32));
    if (SINK) m = fmaxf(m, sink);
    float l = 0.f;
    f32x16 Z[2];
#pragma unroll
    for (int i = 0; i < 16; ++i) { Z[0][i] = 0.f; Z[1][i] = 0.f; }
#pragma unroll
    for (int kt = 0; kt < NKT; ++kt) {
        const int kte = kt < nskip ? nskip : kt;
        const bf16* kr = kbase + (koff + (ptrdiff_t)(32 * kte + r) * kpitch + 8 * hh);
        f32x16 a;
#pragma unroll
        for (int i = 0; i < 16; ++i) a[i] = 0.f;
#pragma unroll
        for (int s = 0; s < 4; ++s) a = MFMA32(*(const bf16x8*)(kr + 16 * s), qf[s], a);
#pragma unroll
        for (int i = 0; i < 16; ++i) { const float p = (kt < nskip) ? 0.f : __expf(a[i] * scale - m); a[i] = p; l += p; }
#pragma unroll
        for (int s = 0; s < 2; ++s) {
            const bf16x8 pa = pack8(a, s, 1.f);
#pragma unroll
            for (int nt = 0; nt < 2; ++nt) {
                const bf16* vr = vbase + (voff + (ptrdiff_t)(32 * nt + r) * vpitch + 32 * kte + 16 * s + 4 * hh);
                const s16x4 lo = *(const s16x4*)vr, hi = *(const s16x4*)(vr + 8);
                const bf16x8 bv = __builtin_shufflevector(lo, hi, 0, 1, 2, 3, 4, 5, 6, 7);
                Z[nt] = MFMA32(pa, bv, Z[nt]);
            }
        }
        asm volatile("" ::: "memory");
    }
    l += __shfl_xor(l, 32);
    if (SINK) l += __expf(sink - m);
    const float inv = 1.f / l;
#pragma unroll
    for (int i = 0; i < 16; ++i) { const int qq = (i & 3) + 8 * (i >> 2) + 4 * hh; const float iq = __shfl(inv, qq);
        op[(size_t)qq * opitch + r] = (bf16)(cvtpk(Z[0][i] * iq, 0.f) & 0xffffu); op[(size_t)qq * opitch + 32 + r] = (bf16)(cvtpk(Z[1][i] * iq, 0.f) & 0xffffu); }
}

#define GLDS16(gp, lp) __builtin_amdgcn_global_load_lds((const unsigned*)(gp), (LAS unsigned*)(lp), 16, 0, 0)
#define WAITV(n) asm volatile("s_waitcnt vmcnt(" #n ")" ::: "memory")
#define RAWBAR() do { asm volatile("s_waitcnt lgkmcnt(0)" ::: "memory"); __builtin_amdgcn_s_barrier(); asm volatile("" ::: "memory"); } while (0)
constexpr int GS_KD = 0, GS_V = 16384, GS_A = 20480, GS_KDV = 21504, GS_QR = 3 * GS_KDV, GS_QS = 16384, GS_SX = GS_QR + 4 * GS_QS, GS_SXP = 272, GS_SXB = 32 * GS_SXP;
#define GLA_ISSUE_KDV(cc, slot) do { LAS unsigned char* sb_ = lds + (slot) * GS_KDV; const size_t cho_ = (size_t)(b * 128 + (cc)) * 32768; \
    _Pragma("unroll") for (int i_ = 0; i_ < 4; ++i_) GLDS16(KdT + cho_ + okd[i_], sb_ + GS_KD + (4 * w + i_) * 1024); \
    GLDS16(vbase + ov + (cc) * 64, sb_ + GS_V + w * 1024); \
    if (w == 0) GLDS16(abase + (size_t)(cc) * 512, sb_ + GS_A); } while (0)
#define GLA_ISSUE_Q(cc, slot) do { LAS unsigned char* sb_ = lds + GS_QR + (slot) * GS_QS; const size_t cho_ = (size_t)(b * 128 + (cc)) * 32768; \
    _Pragma("unroll") for (int i_ = 0; i_ < 4; ++i_) GLDS16(QG + cho_ + oq[i_], sb_ + (4 * w + i_) * 1024); } while (0)
template <int ABL>
__device__ __forceinline__ void gla_scan(int b, int h, int vs, const bf16* KdT, const float* Adec, const bf16* VTg, const bf16* QG, bf16* ORAW, LAS unsigned char* lds, int tid) {
    const int lane = tid & 63, w = __builtin_amdgcn_readfirstlane(tid >> 6), wk = w & 3, r = lane & 31, hh = lane >> 5, l16 = lane & 15, quad = lane >> 4;
    unsigned okd[4], oq[4], ov;
#pragma unroll
    for (int i = 0; i < 4; ++i) { const int row = 32 * wk + 8 * i + (lane >> 3), lch = (lane & 7) ^ ((row >> 1) & 7); okd[i] = (unsigned)((h * 128 + row) * 64 + lch * 8); }
#pragma unroll
    for (int i = 0; i < 4; ++i) { const int row = 16 * wk + 4 * i + (lane >> 4), lch = (lane & 15) ^ (row & 15); oq[i] = (unsigned)(row * 512 + h * 128 + lch * 8); }
    { const int row = 8 * wk + (lane >> 3), lch = (lane & 7) ^ ((row >> 1) & 7); ov = (unsigned)((vs * 32 + row) * 8192 + lch * 8); }
    const bf16* vbase = VTg + (size_t)(b * 1024 + h * 256) * 8192;
    const float* abase = Adec + (size_t)(b * 128) * 512 + (h & ~1) * 128 + 4 * lane;
    int rkd[4], rv[4], rq[4];
#pragma unroll
    for (int s = 0; s < 4; ++s) { const int rowk = 32 * wk + r, rowv = r;
        rkd[s] = rowk * 128 + (((2 * s + hh) ^ ((rowk >> 1) & 7)) * 16); rv[s] = rowv * 128 + (((2 * s + hh) ^ ((rowv >> 1) & 7)) * 16); }
    const int jt = w & 3;
#pragma unroll
    for (int ks = 0; ks < 4; ++ks) { const int rowq = 16 * jt + l16; rq[ks] = rowq * 256 + (((4 * ks + quad) ^ (rowq & 15)) * 16); }
    const int aoff = ((h & 1) * 128 + 32 * wk + 4 * hh) * 4;
    const int sxw = r * GS_SXP + (32 * wk + 4 * hh) * 2;
    const int sxr = l16 * GS_SXP + 16 * quad;
    f32x16 S;
#pragma unroll
    for (int i = 0; i < 16; ++i) S[i] = 0.f;
    if (w < 4) { GLA_ISSUE_KDV(0, 0); GLA_ISSUE_Q(0, 0); GLA_ISSUE_KDV(1, 1); GLA_ISSUE_Q(1, 1); }
    int sk = 0, sq = 0;
    for (int i = 0; i <= 128; ++i) {
        if (w < 4) { if (i < 126) { if (w == 0) WAITV(14); else WAITV(13); } else WAITV(0); }
        RAWBAR();
        if (w < 4) {
            if (i < 128) {
                LAS unsigned char* sb = lds + sk * GS_KDV;
                bf16x8 ka[4], vb[4]; f32x4 a4[4];
                ka[2] = *(const LAS bf16x8*)(sb + GS_KD + rkd[2]); vb[2] = *(const LAS bf16x8*)(sb + GS_V + rv[2]);
                ka[3] = *(const LAS bf16x8*)(sb + GS_KD + rkd[3]); vb[3] = *(const LAS bf16x8*)(sb + GS_V + rv[3]);
#pragma unroll
                for (int q = 0; q < 4; ++q) a4[q] = *(const LAS f32x4*)(sb + GS_A + aoff + 32 * q);
                ka[0] = *(const LAS bf16x8*)(sb + GS_KD + rkd[0]); vb[0] = *(const LAS bf16x8*)(sb + GS_V + rv[0]);
                ka[1] = *(const LAS bf16x8*)(sb + GS_KD + rkd[1]); vb[1] = *(const LAS bf16x8*)(sb + GS_V + rv[1]);
                f32x16 U;
#pragma unroll
                for (int ii = 0; ii < 16; ++ii) U[ii] = 0.f;
                U = MFMA32(ka[2], vb[2], U); U = MFMA32(ka[3], vb[3], U);
#pragma unroll
                for (int ii = 0; ii < 16; ++ii) S[ii] *= a4[ii >> 2][ii & 3];
                S = MFMA32(ka[0], vb[0], S); S = MFMA32(ka[1], vb[1], S);
                __builtin_amdgcn_sched_barrier(0);
                if (i + 2 < 128) { const int s2 = sk == 0 ? 2 : sk - 1; GLA_ISSUE_KDV(i + 2, s2); }
                __builtin_amdgcn_sched_barrier(0);
#pragma unroll
                for (int ii = 0; ii < 16; ++ii) S[ii] += U[ii];
                LAS unsigned char* sxb = lds + GS_SX + (i & 1) * GS_SXB;
#pragma unroll
                for (int q = 0; q < 4; ++q) { v2u pkd; pkd.x = cvtpk(S[4 * q], S[4 * q + 1]); pkd.y = cvtpk(S[4 * q + 2], S[4 * q + 3]); *(LAS v2u*)(sxb + sxw + 16 * q) = pkd; }
                if (i + 2 < 128) { const int q2 = (i + 2) & 3; GLA_ISSUE_Q(i + 2, q2); }
            }
        } else if (i >= 1) {
            const int c = i - 1;
            const LAS unsigned char* qb = lds + GS_QR + (c & 3) * GS_QS;
            const LAS unsigned char* sxb = lds + GS_SX + (c & 1) * GS_SXB;
            bf16x8 qa[4];
#pragma unroll
            for (int ks = 0; ks < 4; ++ks) qa[ks] = *(const LAS bf16x8*)(qb + rq[ks]);
            bf16* orow = ORAW + ((size_t)((b * 128 + c) * 64 + 16 * jt + 4 * quad)) * 1024 + h * 256 + vs * 32 + l16;
#pragma unroll
            for (int vt = 0; vt < 2; ++vt) {
                f32x4 o = {0.f, 0.f, 0.f, 0.f};
#pragma unroll
                for (int ks = 0; ks < 4; ++ks) o = MFMA16(qa[ks], *(const LAS bf16x8*)(sxb + vt * 16 * GS_SXP + sxr + 64 * ks), o);
#pragma unroll
                for (int j = 0; j < 4; ++j) { if (!(ABL & 1)) orow[(size_t)j * 1024 + 16 * vt] = (bf16)(cvtpk(o[j] * 0.08838834764831845f, 0.f) & 0xffffu); else asm volatile("" :: "v"(o[j])); }
            }
        }
        sk = sk == 2 ? 0 : sk + 1;
    }
    WAITV(0); RAWBAR();
}
constexpr int SW_KP = 144, SW_VP = 400, SW_V0 = 192 * SW_KP, SW_BUF = SW_V0 + 64 * SW_VP;
__device__ __forceinline__ void swa_fetch(int js, const bf16* KA, const bf16* VTA, int tid, v4u (&kr)[3], v4u (&vr)[3]) {
    const int b = js >> 8, c = (js >> 1) & 127, g = js & 1, nsk = c < 2 ? 64 * (2 - c) : 0;
    const ptrdiff_t krow0 = (ptrdiff_t)b * 8192 + (c - 2) * 64;
#pragma unroll
    for (int i = 0; i < 3; ++i) { const int p = tid + 512 * i, row = p >> 3, ch = p & 7;
        kr[i] = (row >= nsk) ? *(const v4u*)(KA + (krow0 + row) * 128 + g * 64 + ch * 8) : (v4u){0u, 0u, 0u, 0u}; }
#pragma unroll
    for (int i = 0; i < 3; ++i) { const int p = tid + 512 * i, d = p / 24, ch = p - 24 * d;
        vr[i] = (ch * 8 >= nsk) ? *(const v4u*)(VTA + ((ptrdiff_t)(b * 128 + g * 64 + d)) * 8192 + (c - 2) * 64 + ch * 8) : (v4u){0u, 0u, 0u, 0u}; }
}
__device__ __forceinline__ void swa_stash(LAS unsigned char* buf, int tid, const v4u (&kr)[3], const v4u (&vr)[3]) {
#pragma unroll
    for (int i = 0; i < 3; ++i) { const int p = tid + 512 * i, row = p >> 3, ch = p & 7; *(LAS v4u*)(buf + row * SW_KP + ch * 16) = kr[i]; }
#pragma unroll
    for (int i = 0; i < 3; ++i) { const int p = tid + 512 * i, d = p / 24, ch = p - 24 * d; *(LAS v4u*)(buf + SW_V0 + d * SW_VP + ch * 16) = vr[i]; }
}
template <int NKT, int KP, int VP, int OP, bool SINK>
__device__ __forceinline__ void lds_attend(const bf16* qp, const LAS unsigned char* Ks, const LAS unsigned char* Vts, int nskip, float scale, float sink, bf16* op, int lane) {
    asm volatile("" : "+v"(lane));
    const int r = lane & 31, hh = lane >> 5;
    bf16x8 qf[4];
#pragma unroll
    for (int s = 0; s < 4; ++s) qf[s] = *(const bf16x8*)(qp + 16 * s + 8 * hh);
    const LAS unsigned char* kl = Ks + r * KP + 16 * hh;
    float m = -3.0e38f;
#pragma unroll
    for (int kt = 0; kt < NKT; ++kt) {
        if (kt >= nskip) {
            f32x16 a;
#pragma unroll
            for (int i = 0; i < 16; ++i) a[i] = 0.f;
#pragma unroll
            for (int s = 0; s < 4; ++s) a = MFMA32(*(const LAS bf16x8*)(kl + kt * 32 * KP + 32 * s), qf[s], a);
            float mt = a[0];
#pragma unroll
            for (int i = 1; i < 16; ++i) mt = fmaxf(mt, a[i]);
            m = fmaxf(m, mt * scale);
        }
        asm volatile("" ::: "memory");
    }
    m = fmaxf(m, __shfl_xor(m, 32));
    if (SINK) m = fmaxf(m, sink);
    float l = 0.f;
    f32x16 Z[2];
#pragma unroll
    for (int i = 0; i < 16; ++i) { Z[0][i] = 0.f; Z[1][i] = 0.f; }
    const LAS unsigned char* vl = Vts + r * VP + 8 * hh;
#pragma unroll
    for (int kt = 0; kt < NKT; ++kt) {
        if (kt >= nskip) {
            f32x16 a;
#pragma unroll
            for (int i = 0; i < 16; ++i) a[i] = 0.f;
#pragma unroll
            for (int s = 0; s < 4; ++s) a = MFMA32(*(const LAS bf16x8*)(kl + kt * 32 * KP + 32 * s), qf[s], a);
#pragma unroll
            for (int i = 0; i < 16; ++i) { const float p = __expf(a[i] * scale - m); a[i] = p; l += p; }
#pragma unroll
            for (int s = 0; s < 2; ++s) {
                const bf16x8 pa = pack8(a, s, 1.f);
#pragma unroll
                for (int nt = 0; nt < 2; ++nt) {
                    const LAS unsigned char* vp = vl + nt * 32 * VP + (32 * kt + 16 * s) * 2;
                    const s16x4 lo = *(const LAS s16x4*)vp, hi = *(const LAS s16x4*)(vp + 16);
                    const bf16x8 bv = __builtin_shufflevector(lo, hi, 0, 1, 2, 3, 4, 5, 6, 7);
                    Z[nt] = MFMA32(pa, bv, Z[nt]);
                }
            }
        }
        asm volatile("" ::: "memory");
    }
    l += __shfl_xor(l, 32);
    if (SINK) l += __expf(sink - m);
    const float inv = 1.f / l;
#pragma unroll
    for (int i = 0; i < 16; ++i) { const int qq = (i & 3) + 8 * (i >> 2) + 4 * hh; const float iq = __shfl(inv, qq);
        op[(size_t)qq * OP + r] = (bf16)(cvtpk(Z[0][i] * iq, 0.f) & 0xffffu); op[(size_t)qq * OP + 32 + r] = (bf16)(cvtpk(Z[1][i] * iq, 0.f) & 0xffffu); }
}
__device__ __forceinline__ void swa_phase(int j0, int jstride, int njobs, const bf16* QA, bf16* OA, const bf16* KA, const bf16* VTA, const float* sinks, LAS unsigned char* lds, int tid) {
    asm volatile("" : "+v"(tid));
    const int lane = tid & 63, wave = __builtin_amdgcn_readfirstlane(tid >> 6);
    if (j0 >= njobs) return;
    v4u kr[3], vr[3];
    swa_fetch(j0, KA, VTA, tid, kr, vr);
    swa_stash(lds, tid, kr, vr);
    __syncthreads();
    int buf = 0;
    for (int js = j0; js < njobs; js += jstride) {
        const int jn = js + jstride; const bool more = jn < njobs;
        if (more) swa_fetch(jn, KA, VTA, tid, kr, vr);
        const int b = js >> 8, c = (js >> 1) & 127, g = js & 1, hq = 8 * g + wave;
        const int nskip = c < 2 ? 2 * (2 - c) : 0;
        const size_t trow0 = (size_t)b * 8192 + c * 64;
        const float sk = sinks[hq];
        const LAS unsigned char* Ks = lds + buf * SW_BUF;
#pragma unroll 1
        for (int qg = 0; qg < 2; ++qg)
            lds_attend<6, SW_KP, SW_VP, 1024, true>(QA + (trow0 + 32 * qg + (lane & 31)) * 1024 + hq * 64, Ks, Ks + SW_V0, nskip, 0.125f, sk, OA + (trow0 + 32 * qg) * 1024 + hq * 64, lane);
        if (more) swa_stash(lds + (buf ^ 1) * SW_BUF, tid, kr, vr);
        __syncthreads();
        buf ^= 1;
    }
}
__device__ __forceinline__ void sub_barrier(unsigned* ctr, unsigned n) {
    asm volatile("s_waitcnt vmcnt(0)" ::: "memory");
    __syncthreads();
    if (threadIdx.x == 0) {
        __builtin_amdgcn_fence(__ATOMIC_RELEASE, "agent"); asm volatile("s_waitcnt vmcnt(0)" ::: "memory");
        __hip_atomic_fetch_add(ctr, 1u, __ATOMIC_RELAXED, __HIP_MEMORY_SCOPE_AGENT);
        unsigned sp = 0;
        while (__hip_atomic_load(ctr, __ATOMIC_RELAXED, __HIP_MEMORY_SCOPE_AGENT) < n) { __builtin_amdgcn_s_sleep(2); if (++sp > (1u << 24)) break; }
        __builtin_amdgcn_fence(__ATOMIC_ACQUIRE, "agent"); asm volatile("s_waitcnt vmcnt(0)" ::: "memory");
    }
    __syncthreads();
}
struct Args { const float* in[22]; float* out; unsigned char* ws; int ph_lo, ph_hi, dry, pad; };
#ifndef MK_N_LAUNCHES
#define MK_N_LAUNCHES 1
#endif

#define X_IN (args.in[0])
#define MEM_IN (args.in[1])
#define norm_mix_w (args.in[2])
#define w_in (args.in[3])
#define b_gate (args.in[4])
#define sinks (args.in[5])
#define gate_w2 (args.in[6])
#define gate_b (args.in[7])
#define gla_norm_w (args.in[8])
#define w_attn_o (args.in[9])
#define w_gla_o (args.in[10])
#define w_mix_o (args.in[11])
#define norm_mem_q_w (args.in[12])
#define norm_mem_kv_w (args.in[13])
#define w_mem_q (args.in[14])
#define w_mem_kv (args.in[15])
#define w_mem_o (args.in[16])
#define norm_ffn_w (args.in[17])
#define w_ffn_gate (args.in[18])
#define w_ffn_up (args.in[19])
#define w_ffn_down (args.in[20])
#define norm_final_w (args.in[21])
#define OUT_P (args.out)
#define WSB(off) ((bf16*)(args.ws + (off)))
#define SSQ1 ((float*)(args.ws + WS_SSQ))
#define SSQ2 (SSQ1 + T)
#define SSQ3 (SSQ1 + 2 * T)
#define ADEC ((float*)(args.ws + WS_ADEC))
#define KM WSB(WS_KM)
#define VMT WSB(WS_VMT)
#define MN WSB(WS_MN)
#define WALR WSB(WS_WALR)
#define WIN WSB(WS_WIN)
#define WAO WSB(WS_WAO)
#define WGO WSB(WS_WGO)
#define WMIX WSB(WS_WMIX)
#define WMKV WSB(WS_WMKV)
#define HB WSB(WS_H)
#define QA WSB(WS_QA)
#define QM WSB(WS_QM)
#define OM WSB(WS_OM)
#define KA WSB(WS_KA)
#define VTA WSB(WS_VTA)
#define QG WSB(WS_QG)
#define KG WSB(WS_KG)
#define MERGED WSB(WS_MERGED)
#define OGB WSB(WS_OG)
#define VTG WSB(WS_VTG)
#define WGU WSB(WS_WGU)
#define WD WSB(WS_WD)
#define WMQ WSB(WS_WMQ)
#define WMO WSB(WS_WMO)
#define GG WSB(WS_GG)
#define ORAWB ((bf16*)OUT_P)
#define TMP ((bf16*)OUT_P + (size_t)T * 1024)
#define ACT WSB(WS_ACT)
#define GT WSB(WS_GT)
__global__ void __launch_bounds__(512, 2) mk_fwd(Args args) {
    extern __shared__ __attribute__((aligned(16))) unsigned char lds_raw[];
    LAS unsigned char* lds = (LAS unsigned char*)lds_raw;
    const int tid = threadIdx.x, lane = tid & 63, wave = __builtin_amdgcn_readfirstlane(tid >> 6);
    const int G = gridDim.x, bx = blockIdx.x;
    const int gw = bx * 8 + wave, NGW = G * 8;
    const int lo = args.ph_lo, hi = args.ph_hi;
#define IN(k) (lo <= (k) && (k) < hi)
#ifndef P10_ALIGN
#define P10_ALIGN true
#endif
#ifndef PHMASK
#define PHMASK 0xffff
#endif
#ifndef DUPPH
#define DUPPH -1
#endif
#define PHEN(k) (((PHMASK) >> (k)) & 1)
#define SEAM(k) do { if (IN(k) && IN((k) + 1)) { if ((k) == 0) cg::this_grid().sync(); else { XcdBarrier xb_; xb_.bar = (unsigned*)(args.ws + WS_BAR); xb_.x = xb_xcc_id(); xb_.st = MISC + 8; xcd_barrier(xb_); } } } while (0)
    LAS float* scr = (LAS float*)(lds + wave * 8448);
    volatile LAS unsigned* MISC = (volatile LAS unsigned*)(lds + MISC_OFF);
    if (tid < 16) MISC[tid] = 0u;
    __syncthreads();
    XcdBarrier xbar; xbar.bar = (unsigned*)(args.ws + WS_BAR); xbar.x = 0; xbar.st = nullptr;

    if (PHEN(0) && IN(0)) for (int rep_ = 0; rep_ < ((DUPPH == 0) ? 2 : 1); ++rep_) {
        constexpr int I_IN = 200 * 16, I_SQ = 32 * 16, I_KV = 16 * 16, I_MQ = 8 * 16, I_MO = 32 * 4, NIT = I_IN + 3 * I_SQ + I_KV + I_MQ + I_MO;
        for (int it = gw; it < NIT; it += NGW) {
            int r = it;
            if (r < I_IN) { const int nb = r % 200, kb = r / 200, n0 = 32 * nb; transpose_item(w_in, INC, n0 + (n0 >= 4352 ? 16 : 0), 64 * kb, WIN, 1024, n0, nullptr, scr, lane); continue; } r -= I_IN;
            if (r < I_SQ) { transpose_item(w_attn_o, 1024, 32 * (r & 31), 64 * (r >> 5), WAO, 1024, 32 * (r & 31), nullptr, scr, lane); continue; } r -= I_SQ;
            if (r < I_SQ) { transpose_item(w_gla_o, 1024, 32 * (r & 31), 64 * (r >> 5), WGO, 1024, 32 * (r & 31), nullptr, scr, lane); continue; } r -= I_SQ;
            if (r < I_SQ) { transpose_item(w_mix_o, 1024, 32 * (r & 31), 64 * (r >> 5), WMIX, 1024, 32 * (r & 31), nullptr, scr, lane); continue; } r -= I_SQ;
            if (r < I_KV) { transpose_item(w_mem_kv, 512, 32 * (r & 15), 64 * (r >> 4), WMKV, 1024, 32 * (r & 15), nullptr, scr, lane); continue; } r -= I_KV;
            if (r < I_MQ) { transpose_item(w_mem_q, 256, 32 * (r & 7), 64 * (r >> 3), WMQ, 1024, 32 * (r & 7), norm_mem_q_w, scr, lane); continue; } r -= I_MQ;
            transpose_item(w_mem_o, 1024, 32 * (r & 31), 64 * (r >> 5), WMO, 256, 32 * (r & 31), nullptr, scr, lane);
        }
        for (int e = bx * 512 + tid; e < 16 * 1024; e += G * 512) { const int r = e >> 10, k = e & 1023; WALR[e] = (bf16)(cvtpk(w_in[(size_t)k * INC + 4352 + r], 0.f) & 0xffffu); }
        for (int e = bx * 512 + tid; e < 3 * T; e += G * 512) SSQ1[e] = 0.f;
        for (int e = bx * 512 + tid; e < 8192; e += G * 512) ((unsigned*)(args.ws + WS_BAR))[e] = 0u;
        for (int m = gw; m < T; m += 4 * NGW) rms_row4_bf16(X_IN + (size_t)m * D, (size_t)NGW * D, norm_mix_w, HB + (size_t)m * D, lane);
        for (int m = gw; m < 512; m += NGW) rms_row_bf16(MEM_IN + (size_t)m * D, norm_mem_kv_w, MN + (size_t)m * D, lane);
    }
    SEAM(0);
    if (hi - lo > 1) (void)xcd_barrier_post((unsigned*)(args.ws + WS_BAR), MISC + 8);
    if (PHEN(1) && IN(1)) {
        pg8::Gemm g{HB, WIN, T, 6144, D}; pg8::StaticOrder S; S.init(T, 6144, G, bx);
        pg8::EpiProj E{QA, KA, VTA, QG, KG, VTG, GG, GT, b_gate};
        pg8::gemm_phase<pg8::EpiProj, pg8::StaticOrder, true, true>(lds, g, S, E);
    }
    SEAM(1);
    if (PHEN(2) && IN(2)) { int td2 = tid; asm volatile("" : "+v"(td2)); for (int ch = bx; ch < 256; ch += G) gla_prep(ch, HB, WALR, gate_w2, gate_b, KG, args.dry ? (bf16*)OUT_P : KG, args.dry ? OUT_P + 16 * 1024 * 1024 : ADEC, lds, td2); }
    SEAM(2);
    if (PHEN(3) && IN(3)) {
        constexpr int NGLA = 64, NSWA = 512;
        int ln3 = lane, td3 = tid; asm volatile("" : "+v"(ln3), "+v"(td3));
        if (bx < NGLA) { gla_scan<0>((bx >> 2) & 1, bx & 3, bx >> 3, KG, ADEC, VTG, QG, ORAWB, lds, td3);
#ifdef GLA_ABL
            gla_scan<GLA_ABL>((bx >> 2) & 1, bx & 3, bx >> 3, KG, ADEC, VTG, QG, ORAWB, lds, td3);
#endif
        }
        else {
            swa_phase(bx - NGLA, G - NGLA, NSWA, QA, args.dry ? HB : QA, KA, VTA, sinks, lds, td3);
            const int p = bx - NGLA;
            sub_barrier((unsigned*)(args.ws + WS_BAR + 14336), (unsigned)(G - NGLA));
            if (p < 64) {
                { pg8::Gemm g{HB, WIN, T, NPROJ, D}; pg8::OneUnit S{p, 24};
                  pg8::EpiProj E{QA, KA, VTA, QG, KG, VTG, GG, GT, b_gate};
                  pg8::gemm_phase<pg8::EpiProj, pg8::OneUnit, true, true>(lds, g, S, E); }
                if (p < 4) { pg8::Gemm g{MN, WMKV, 512, 512, D}; pg8::OneUnit S{p >> 1, p & 1};
                  pg8::EpiMemKV E{KM, VMT};
                  pg8::gemm_phase<pg8::EpiMemKV, pg8::OneUnit, true, true>(lds, g, S, E); }
            } else { pg8::Gemm g{QA, WAO, T, D, D}; pg8::StrideOrder S{p - 64, G - NGLA - 64, 256}; pg8::EpiGate E{GT, TMP, MERGED, 0};
              pg8::gemm_phase<pg8::EpiGate, pg8::StrideOrder, true, true>(lds, g, S, E);
            }
        }
    }
    SEAM(3);
    if (PHEN(4) && IN(4)) for (int rep_ = 0; rep_ < ((DUPPH == 4) ? 2 : 1); ++rep_) {
        const f32x4 w4 = *(const f32x4*)(gla_norm_w + 4 * lane);
        for (int it0 = gw; it0 < T * 4; it0 += 8 * NGW) {
            v2u ov[8], gv[8]; float ss[8];
#pragma unroll
            for (int u = 0; u < 8; ++u) { const size_t off = (size_t)(it0 + u * NGW) * 256 + 4 * lane; ov[u] = *(const v2u*)(ORAWB + off); gv[u] = *(const v2u*)(GG + off); }
#pragma unroll
            for (int u = 0; u < 8; ++u) { const f32x4 v = {__uint_as_float(ov[u].x << 16), __uint_as_float(ov[u].x & 0xffff0000u), __uint_as_float(ov[u].y << 16), __uint_as_float(ov[u].y & 0xffff0000u)}; ss[u] = dot4(v); }
#pragma unroll
            for (int o = 1; o < 64; o <<= 1) {
#pragma unroll
                for (int u = 0; u < 8; ++u) ss[u] += __shfl_xor(ss[u], o); }
#pragma unroll
            for (int u = 0; u < 8; ++u) { const size_t off = (size_t)(it0 + u * NGW) * 256 + 4 * lane;
                const float rstd = 1.f / sqrtf(ss[u] * (1.f / 256.f) + EPS);
                const f32x4 v = {__uint_as_float(ov[u].x << 16), __uint_as_float(ov[u].x & 0xffff0000u), __uint_as_float(ov[u].y << 16), __uint_as_float(ov[u].y & 0xffff0000u)};
                const f32x4 gr = {__uint_as_float(gv[u].x << 16), __uint_as_float(gv[u].x & 0xffff0000u), __uint_as_float(gv[u].y << 16), __uint_as_float(gv[u].y & 0xffff0000u)};
                const f32x4 sg = gr * pg8::sigm4(gr);
                const f32x4 y = v * rstd * w4 * sg;
                v2u o; o.x = cvtpk(y[0], y[1]); o.y = cvtpk(y[2], y[3]); *(v2u*)(OGB + off) = o; }
        }
    }
    SEAM(4);
    if (PHEN(5) && IN(5)) {
        pg8::StaticOrder S; S.init(T, D, G, bx);
        pg8::Gemm g{OGB, WGO, T, D, D}; pg8::EpiGate E{GT, TMP, MERGED, 1}; pg8::gemm_phase<pg8::EpiGate, pg8::StaticOrder, true, true>(lds, g, S, E);
    }
    SEAM(5);
    if (PHEN(6) && IN(6)) { pg8::Gemm g{MERGED, WMIX, T, D, D}; pg8::StaticOrder S; S.init(T, D, G, bx); pg8::EpiResid E{X_IN, nullptr, nullptr, args.dry ? GG : HB, args.dry ? SSQ3 : SSQ1};
        pg8::gemm_phase<pg8::EpiResid, pg8::StaticOrder, true, true>(lds, g, S, E); }
    SEAM(6);
    if (PHEN(7) && IN(7)) {
        { pg8::Gemm g{HB, WMQ, T, 256, D}; pg8::StaticOrder S; S.init(T, 256, G, bx); pg8::EpiScaleQ E{QM, SSQ1};
          pg8::gemm_phase<pg8::EpiScaleQ, pg8::StaticOrder, true, true>(lds, g, S, E); }
        if (bx >= 64 || G <= 64) {
            constexpr int I_GU = 176 * 16, I_D = 32 * 44, NIT = I_GU + I_D;
            const int gw7 = (G > 64 ? (bx - 64) : bx) * 8 + wave, ngw7 = (G > 64 ? (G - 64) : G) * 8;
            for (int it = gw7; it < NIT; it += ngw7) {
                int r = it;
                if (r < I_GU) { const int nb = r % 176, kb = r / 176, n0 = 32 * nb, pn = n0 >> 8, r0 = n0 & 255;
                    transpose_item(r0 < 128 ? w_ffn_gate : w_ffn_up, DFF, 128 * pn + (r0 & 127), 64 * kb, WGU, 1024, n0, norm_ffn_w, scr, lane); continue; } r -= I_GU;
                transpose_item(w_ffn_down, 1024, 32 * (r & 31), 64 * (r >> 5), WD, DFF, 32 * (r & 31), nullptr, scr, lane);
            }
        }
    }
    SEAM(7);
    if (PHEN(8) && IN(8)) for (int rep_ = 0; rep_ < ((DUPPH == 8) ? 2 : 1); ++rep_) {
        constexpr int XK = 144, XV = 528, XV0 = 256 * XK;
        int td8 = tid; asm volatile("" : "+v"(td8));
        for (int j = bx; j < 256; j += G) {
            const int hm = j & 3, qt = j >> 2, b = qt >> 5;
            v4u kr[4], vr[4];
#pragma unroll
            for (int i = 0; i < 4; ++i) { const int pc = td8 + 512 * i; kr[i] = *(const v4u*)(KM + (size_t)(b * 256 + (pc >> 3)) * 256 + hm * 64 + (pc & 7) * 8);
                vr[i] = *(const v4u*)(VMT + (size_t)(b * 256 + hm * 64 + (pc >> 5)) * 256 + (pc & 31) * 8); }
#pragma unroll
            for (int i = 0; i < 4; ++i) { const int pc = td8 + 512 * i; *(LAS v4u*)(lds + (pc >> 3) * XK + (pc & 7) * 16) = kr[i]; *(LAS v4u*)(lds + XV0 + (pc >> 5) * XV + (pc & 31) * 16) = vr[i]; }
            __syncthreads();
            const int q0 = qt * 256 + 32 * wave;
            lds_attend<8, XK, XV, 256, false>(QM + (size_t)(q0 + (td8 & 31)) * 256 + hm * 64, lds, lds + XV0, 0, 1.0f, 0.f, OM + (size_t)q0 * 256 + hm * 64, td8 & 63);
            __syncthreads();
        }
    }
    SEAM(8);
    if (PHEN(9) && IN(9)) { pg8::Gemm g{OM, WMO, T, D, 256}; pg8::StaticOrder S; S.init(T, D, G, bx); pg8::EpiResid E{nullptr, HB, nullptr, args.dry ? GG : HB, args.dry ? SSQ3 : SSQ2};
        pg8::gemm_phase<pg8::EpiResid, pg8::StaticOrder, true, true>(lds, g, S, E); }
    SEAM(9);
    if (PHEN(10) && IN(10)) for (int rep_ = 0; rep_ < ((DUPPH == 10) ? 2 : 1); ++rep_) { pg8::Gemm g{HB, WGU, T, 2 * DFF, D}; pg8::StaticOrder S; S.init(T, 2 * DFF, G, bx); pg8::EpiSwiglu E{ACT, SSQ2};
        pg8::gemm_phase<pg8::EpiSwiglu, pg8::StaticOrder, true, true>(lds, g, S, E); }
    SEAM(10);
    if (PHEN(11) && IN(11)) {
        pg8::Gemm g{ACT, WD, T, D, DFF}; pg8::StaticOrder S; S.init(T, D, G, bx);
        if (G == 256 && !args.dry) {
            pg8::EpiFinal E{HB, OUT_P, norm_final_w, (float*)(args.ws + WS_XSLOT), (unsigned*)(args.ws + WS_BAR + 16384)};
            pg8::gemm_phase<pg8::EpiFinal, pg8::StaticOrder, false, true>(lds, g, S, E);
        } else {
            pg8::EpiResid E{nullptr, HB, args.dry ? (float*)(args.ws + WS_QA) : OUT_P, nullptr, nullptr};
            pg8::gemm_phase<pg8::EpiResid, pg8::StaticOrder, true, true>(lds, g, S, E);
        }
    }
    if (G != 256 || args.dry) SEAM(11);
    if (PHEN(12) && IN(12) && (G != 256 || args.dry)) {
        const f32x4* wr = (const f32x4*)norm_final_w + lane;
        for (int m0 = gw; m0 < T; m0 += 4 * NGW) {
            f32x4 v[4][4]; float s[4] = {0.f, 0.f, 0.f, 0.f};
#pragma unroll
            for (int u = 0; u < 4; ++u) { const f32x4* xr = (const f32x4*)(OUT_P + (size_t)(m0 + u * NGW) * D) + lane;
#pragma unroll
                for (int j = 0; j < 4; ++j) { v[u][j] = xr[64 * j]; s[u] += dot4(v[u][j]); } }
#pragma unroll
            for (int o = 1; o < 64; o <<= 1) {
#pragma unroll
                for (int u = 0; u < 4; ++u) s[u] += __shfl_xor(s[u], o); }
#pragma unroll
            for (int u = 0; u < 4; ++u) { f32x4* xr = (f32x4*)((args.dry ? (float*)(args.ws + WS_QA) : OUT_P) + (size_t)(m0 + u * NGW) * D) + lane; const float rstd = 1.f / sqrtf(s[u] * (1.f / 1024.f) + EPS);
#pragma unroll
                for (int j = 0; j < 4; ++j) xr[64 * j] = v[u][j] * rstd * wr[64 * j]; }
        }
    }
#undef IN
#undef SEAM
}

extern "C" void kernel_launch(void* const* d_in, const int* in_sizes, int n_in, void* d_out, int out_size, void* d_ws, size_t ws_size, hipStream_t stream) {
    static int grid = 0;
    if (grid == 0) {
        int dev = 0, cus = 0, per_cu = 0;
        hipGetDevice(&dev);
        hipDeviceGetAttribute(&cus, hipDeviceAttributeMultiprocessorCount, dev);
        if (hipFuncSetAttribute((const void*)mk_fwd, hipFuncAttributeMaxDynamicSharedMemorySize, LDS_BYTES) != hipSuccess) { fprintf(stderr, "kernel_launch: hipFuncSetAttribute failed\n"); }
        if (hipOccupancyMaxActiveBlocksPerMultiprocessor(&per_cu, (const void*)mk_fwd, 512, LDS_BYTES) != hipSuccess || per_cu < 1) { fprintf(stderr, "kernel_launch: occupancy query gave %d\n", per_cu); per_cu = 1; }
        (void)hipGetLastError();
        if (per_cu > 1) per_cu = 1;
        grid = cus * per_cu;
        if (n_in != 22 || ws_size < 256 * MiB) fprintf(stderr, "kernel_launch: unexpected n_in %d / ws %zu\n", n_in, ws_size);
    }
    Args a{};
    for (int i = 0; i < 22; ++i) a.in[i] = (const float*)d_in[i];
    a.out = (float*)d_out; a.ws = (unsigned char*)d_ws;
#if MK_N_LAUNCHES == 1
    a.ph_lo = 0; a.ph_hi = NPH;
    void* kargs[] = {&a};
    hipError_t e = hipLaunchCooperativeKernel((const void*)mk_fwd, dim3(grid), dim3(512), kargs, LDS_BYTES, stream);
    if (e != hipSuccess) fprintf(stderr, "cooperative launch failed: %s (grid %d)\n", hipGetErrorString(e), grid);
#else
    for (int li = 0; li < NPH; ++li) { a.ph_lo = li; a.ph_hi = li + 1; hipLaunchKernelGGL(mk_fwd, dim3(grid), dim3(512), LDS_BYTES, stream, a);
#ifdef DUPLAUNCH
        if (li == DUPLAUNCH) { a.dry = 1; hipLaunchKernelGGL(mk_fwd, dim3(grid), dim3(512), LDS_BYTES, stream, a); a.dry = 0; }
#endif
    }
#endif
}
```
